# Optimizing an MI355X kernel written in HIP

```python
import math
import jax
import jax.numpy as jnp
from jax import lax
import numpy as np

D_MODEL = 1024
BATCH = 4
SEQ = 4096
DEPTH = 2

HEAD_DIM = 64
A_HEADS = 4
MOBA_BLOCK = 256
MOBA_TOPK = 3
MOBA_Q_CHUNK = 128
B_HEADS = 8
B_KV_HEADS = 2
WINDOW = 128
C_HEADS = 4
SB_Q_BLOCK = 128
MEM_LEN = 256
X_HEADS = 4
X_HEAD_DIM = 128
D_FF = 2816
N_EXPERTS = 8
TOP_K = 2
D_FF_EXPERT = 3584

ROPE_THETA = 10000.0
EPS = 1e-6
N_BRANCH = 3

A_W = A_HEADS * HEAD_DIM
B_QW = B_HEADS * HEAD_DIM
B_KVW = B_KV_HEADS * HEAD_DIM
C_W = C_HEADS * HEAD_DIM
X_W = X_HEADS * X_HEAD_DIM
IN_W = 3 * A_W + B_QW + 2 * B_KVW + 3 * C_W + N_BRANCH * D_MODEL
N_DENSE = (DEPTH + 1) // 2
N_MOE = DEPTH // 2

kernel_name = "hybrid_moba_swa_stickbreak_gated_moe"

F32 = jnp.float32


def rms_norm(x, g):
    x32 = x.astype(F32)
    y = x32 * lax.rsqrt(jnp.mean(x32 * x32, axis=-1, keepdims=True) + EPS)
    return y.astype(x.dtype) * g


def split_heads(t, n_heads):
    b, s, _ = t.shape
    return t.reshape(b, s, n_heads, -1).transpose(0, 2, 1, 3)


def merge_heads(t):
    b, h, s, dh = t.shape
    return t.transpose(0, 2, 1, 3).reshape(b, s, h * dh)


def rope(x):
    s, dh = x.shape[2], x.shape[3]
    half = dh // 2
    inv_freq = ROPE_THETA ** (-jnp.arange(half, dtype=F32) / half)
    ang = jnp.arange(s, dtype=F32)[:, None] * inv_freq[None, :]
    cos = jnp.cos(ang).astype(x.dtype)
    sin = jnp.sin(ang).astype(x.dtype)
    x1, x2 = x[..., :half], x[..., half:]
    return jnp.concatenate([x1 * cos - x2 * sin, x2 * cos + x1 * sin], axis=-1)


def moba_attention(q, k, v):
    b, h, s, dh = q.shape
    scale = dh ** -0.5
    nb = -(-s // MOBA_BLOCK)
    pad = nb * MOBA_BLOCK - s
    kp = jnp.pad(k, ((0, 0), (0, 0), (0, pad), (0, 0))).reshape(b, h, nb, MOBA_BLOCK, dh)
    vp = jnp.pad(v, ((0, 0), (0, 0), (0, pad), (0, 0))).reshape(b, h, nb, MOBA_BLOCK, dh)
    k_mean = jnp.mean(kp.astype(F32), axis=3).astype(q.dtype)
    k_sel = min(MOBA_TOPK, nb)
    n_chunks = s // MOBA_Q_CHUNK
    qc = q.reshape(b, h, n_chunks, MOBA_Q_CHUNK, dh).transpose(2, 0, 1, 3, 4)
    offs = jnp.arange(MOBA_Q_CHUNK)
    blk_ids = jnp.arange(nb)
    bi = jnp.arange(b)[:, None, None, None]
    hi = jnp.arange(h)[None, :, None, None]

    def chunk(args):
        qi, ci = args
        t = ci * MOBA_Q_CHUNK + offs
        own = (ci * MOBA_Q_CHUNK) // MOBA_BLOCK
        gate = jnp.einsum('bhcd,bhnd->bhcn', qi, k_mean, preferred_element_type=F32)
        gate = jnp.where(blk_ids < own, gate, -jnp.inf)
        _, top_idx = lax.top_k(gate, k_sel)
        rank_ok = jnp.arange(k_sel) < own
        kg = kp[bi, hi, top_idx]
        vg = vp[bi, hi, top_idx]
        lp = jnp.einsum('bhcd,bhcnjd->bhcnj', qi, kg, preferred_element_type=F32) * scale
        lp = jnp.where(rank_ok[None, None, None, :, None], lp, -jnp.inf)
        k_own = lax.dynamic_index_in_dim(kp, own, axis=2, keepdims=False)
        v_own = lax.dynamic_index_in_dim(vp, own, axis=2, keepdims=False)
        lo = jnp.einsum('bhcd,bhjd->bhcj', qi, k_own, preferred_element_type=F32) * scale
        kpos = own * MOBA_BLOCK + jnp.arange(MOBA_BLOCK)
        lo = jnp.where(kpos[None, :] <= t[:, None], lo, -jnp.inf)
        c = qi.shape[2]
        logits = jnp.concatenate([lp.reshape(b, h, c, k_sel * MOBA_BLOCK), lo], axis=-1)
        probs = jax.nn.softmax(logits, axis=-1).astype(v.dtype)
        pp = probs[..., :k_sel * MOBA_BLOCK].reshape(b, h, c, k_sel, MOBA_BLOCK)
        po = probs[..., k_sel * MOBA_BLOCK:]
        return (jnp.einsum('bhcnj,bhcnjd->bhcd', pp, vg)
                + jnp.einsum('bhcj,bhjd->bhcd', po, v_own))

    out = lax.map(chunk, (qc, jnp.arange(n_chunks)))
    return out.transpose(1, 2, 0, 3, 4).reshape(b, h, s, dh)


def swa_sink_attention(q, k, v, sinks):
    b, hq, s, dh = q.shape
    hkv = k.shape[1]
    g = hq // hkv
    nblk = s // WINDOW
    scale = dh ** -0.5
    qb = q.reshape(b, hkv, g, nblk, WINDOW, dh)

    def band(t):
        tb = t.reshape(b, hkv, nblk, WINDOW, dh)
        prev = jnp.pad(tb, ((0, 0), (0, 0), (1, 0), (0, 0), (0, 0)))[:, :, :nblk]
        return jnp.concatenate([prev, tb], axis=3)

    kband, vband = band(k), band(v)
    logits = jnp.einsum('bkgnqd,bknjd->bkgnqj', qb, kband, preferred_element_type=F32) * scale
    qi = jnp.arange(WINDOW)[:, None] + WINDOW
    kj = jnp.arange(2 * WINDOW)[None, :]
    rel = qi - kj
    in_window = (rel >= 0) & (rel < WINDOW)
    has_prev = (jnp.arange(nblk)[:, None, None] > 0) | (kj[None] >= WINDOW)
    mask = in_window[None] & has_prev
    logits = jnp.where(mask, logits, -jnp.inf)
    sink = jnp.broadcast_to(sinks.astype(F32).reshape(1, hkv, g, 1, 1, 1), logits.shape[:-1] + (1,))
    probs = jax.nn.softmax(jnp.concatenate([logits, sink], axis=-1), axis=-1)[..., :-1]
    o = jnp.einsum('bkgnqj,bknjd->bkgnqd', probs.astype(v.dtype), vband)
    return o.reshape(b, hq, s, dh)


def stick_breaking_attention(q, k, v):
    b, h, s, dh = q.shape
    scale = dh ** -0.5
    nblk = s // SB_Q_BLOCK
    qb = q.reshape(b, h, nblk, SB_Q_BLOCK, dh).transpose(2, 0, 1, 3, 4)
    kpos = jnp.arange(s)
    offs = jnp.arange(SB_Q_BLOCK)

    def block(args):
        qi, i = args
        t = i * SB_Q_BLOCK + offs
        z = jnp.einsum('bhqd,bhkd->bhqk', qi, k, preferred_element_type=F32) * scale
        causal = kpos[None, :] < t[:, None]
        log_beta = jax.nn.log_sigmoid(z)
        log_keep = jnp.where(causal, jax.nn.log_sigmoid(-z), 0.0)
        after = lax.cumsum(log_keep, axis=3, reverse=True) - log_keep
        w = jnp.where(causal, jnp.exp(log_beta + after), 0.0)
        return jnp.einsum('bhqk,bhkd->bhqd', w.astype(v.dtype), v)

    out = lax.map(block, (qb, jnp.arange(nblk)))
    return out.transpose(1, 2, 0, 3, 4).reshape(b, h, s, dh)


def gated_mixer(h, w_in, w_proj_a, w_proj_b, w_proj_c, w_mix_out, sinks):
    proj = h @ w_in
    sizes = (A_W, A_W, A_W, B_QW, B_KVW, B_KVW, C_W, C_W, C_W)
    cuts = [int(c) for c in np.cumsum(sizes)]
    qa, ka, va, qb, kb, vb, qc, kc, vc, gates = jnp.split(proj, cuts, axis=-1)
    ya = merge_heads(moba_attention(rope(split_heads(qa, A_HEADS)),
                                    rope(split_heads(ka, A_HEADS)),
                                    split_heads(va, A_HEADS))) @ w_proj_a
    yb = merge_heads(swa_sink_attention(rope(split_heads(qb, B_HEADS)),
                                        rope(split_heads(kb, B_KV_HEADS)),
                                        split_heads(vb, B_KV_HEADS), sinks)) @ w_proj_b
    yc = merge_heads(stick_breaking_attention(split_heads(qc, C_HEADS),
                                              split_heads(kc, C_HEADS),
                                              split_heads(vc, C_HEADS))) @ w_proj_c
    ga, gb, gc = jnp.split(jax.nn.sigmoid(gates), N_BRANCH, axis=-1)
    return (ga * ya + gb * yb + gc * yc) @ w_mix_out


def memory_cross_attention(h, mem_n, w_xq, w_xkv, w_xo):
    q = split_heads(h @ w_xq, X_HEADS)
    k, v = jnp.split(mem_n @ w_xkv, 2, axis=-1)
    k = split_heads(k, X_HEADS)
    v = split_heads(v, X_HEADS)
    logits = jnp.einsum('bhsd,bhmd->bhsm', q, k, preferred_element_type=F32) * (X_HEAD_DIM ** -0.5)
    probs = jax.nn.softmax(logits, axis=-1).astype(v.dtype)
    return merge_heads(jnp.einsum('bhsm,bhmd->bhsd', probs, v)) @ w_xo


def swiglu(h, w_gate, w_up, w_down):
    return (jax.nn.silu(h @ w_gate) * (h @ w_up)) @ w_down


def moe_swiglu(h, w_router, w_gate, w_up, w_down):
    b, s, d = h.shape
    t = h.reshape(b * s, d)
    logits = (t @ w_router).astype(F32)
    top_val, top_idx = lax.top_k(logits, TOP_K)
    top_w = jax.nn.softmax(top_val, axis=-1)
    combine = jnp.sum(jax.nn.one_hot(top_idx, N_EXPERTS, dtype=F32) * top_w[..., None], axis=1)
    combine = combine.astype(t.dtype)
    out = jnp.zeros_like(t)
    for e in range(N_EXPERTS):
        out = out + combine[:, e:e + 1] * swiglu(t, w_gate[e], w_up[e], w_down[e])
    return out.reshape(b, s, d)


def setup_inputs(seed: int = 0) -> dict:
    key = jax.random.key(seed)
    ks = jax.random.split(key, 24)

    def w(k, shape, fan_in):
        return jax.random.normal(k, shape, F32) * (fan_in ** -0.5)

    def gain(k, shape):
        return 1.0 + 0.02 * jax.random.normal(k, shape, F32)

    return {
        "x": jax.random.normal(ks[0], (BATCH, SEQ, D_MODEL), F32),
        "mem": jax.random.normal(ks[1], (BATCH, MEM_LEN, D_MODEL), F32),
        "norm_mix": gain(ks[2], (DEPTH, D_MODEL)),
        "w_in": w(ks[3], (DEPTH, D_MODEL, IN_W), D_MODEL),
        "w_proj_a": w(ks[4], (DEPTH, A_W, D_MODEL), A_W),
        "w_proj_b": w(ks[5], (DEPTH, B_QW, D_MODEL), B_QW),
        "w_proj_c": w(ks[6], (DEPTH, C_W, D_MODEL), C_W),
        "w_mix_out": w(ks[7], (DEPTH, D_MODEL, D_MODEL), D_MODEL),
        "sinks": 0.5 * jax.random.normal(ks[8], (DEPTH, B_HEADS), F32),
        "norm_cross": gain(ks[9], (DEPTH, D_MODEL)),
        "norm_mem": gain(ks[10], (DEPTH, D_MODEL)),
        "w_xq": w(ks[11], (DEPTH, D_MODEL, X_W), D_MODEL),
        "w_xkv": w(ks[12], (DEPTH, D_MODEL, 2 * X_W), D_MODEL),
        "w_xo": w(ks[13], (DEPTH, X_W, D_MODEL), X_W),
        "norm_ffn": gain(ks[14], (DEPTH, D_MODEL)),
        "ffn_gate": w(ks[15], (N_DENSE, D_MODEL, D_FF), D_MODEL),
        "ffn_up": w(ks[16], (N_DENSE, D_MODEL, D_FF), D_MODEL),
        "ffn_down": w(ks[17], (N_DENSE, D_FF, D_MODEL), D_FF),
        "moe_router": w(ks[18], (N_MOE, D_MODEL, N_EXPERTS), D_MODEL),
        "moe_gate": w(ks[19], (N_MOE, N_EXPERTS, D_MODEL, D_FF_EXPERT), D_MODEL),
        "moe_up": w(ks[20], (N_MOE, N_EXPERTS, D_MODEL, D_FF_EXPERT), D_MODEL),
        "moe_down": w(ks[21], (N_MOE, N_EXPERTS, D_FF_EXPERT, D_MODEL), D_FF_EXPERT),
        "final_norm": gain(ks[22], (D_MODEL,)),
    }


def reference(x, mem, norm_mix, w_in, w_proj_a, w_proj_b, w_proj_c, w_mix_out, sinks,
              norm_cross, norm_mem, w_xq, w_xkv, w_xo, norm_ffn,
              ffn_gate, ffn_up, ffn_down, moe_router, moe_gate, moe_up, moe_down,
              final_norm):
    for l in range(DEPTH):
        h = rms_norm(x, norm_mix[l])
        x = x + gated_mixer(h, w_in[l], w_proj_a[l], w_proj_b[l], w_proj_c[l],
                            w_mix_out[l], sinks[l])
        h = rms_norm(x, norm_cross[l])
        mem_n = rms_norm(mem, norm_mem[l])
        x = x + memory_cross_attention(h, mem_n, w_xq[l], w_xkv[l], w_xo[l])
        h = rms_norm(x, norm_ffn[l])
        if l % 2 == 0:
            i = l // 2
            x = x + swiglu(h, ffn_gate[i], ffn_up[i], ffn_down[i])
        else:
            i = l // 2
            x = x + moe_swiglu(h, moe_router[i], moe_gate[i], moe_up[i], moe_down[i])
    return rms_norm(x, final_norm)
```

```cpp
#include <hip/hip_runtime.h>
#include <cstdio>
#include <cstdint>
#include <cmath>

#ifndef PROBE_DOUBLE
#define PROBE_DOUBLE 0
#endif
#define REPS(bit) (1 + ((PROBE_DOUBLE >> (bit)) & 1))
#ifndef XQ8
#define XQ8 1
#endif
#ifndef MOBA_LDS
#define MOBA_LDS 0
#endif
#ifndef KV_I8
#define KV_I8 1
#endif
#ifndef INPROJ_I8
#define INPROJ_I8 1
#endif
#ifndef GATE8_LAYERS
#define GATE8_LAYERS (INPROJ_I8 ? 0 : 3)
#endif
#define LAS __attribute__((address_space(3)))
#define GAS __attribute__((address_space(1)))
typedef unsigned short bf16;
typedef short bf16x8 __attribute__((ext_vector_type(8)));
typedef float f32x4 __attribute__((ext_vector_type(4)));
typedef float f32x2 __attribute__((ext_vector_type(2)));
typedef float f32x16 __attribute__((ext_vector_type(16)));
typedef unsigned u32x4 __attribute__((ext_vector_type(4)));
typedef unsigned u32x2 __attribute__((ext_vector_type(2)));
typedef int i32x8 __attribute__((ext_vector_type(8)));
typedef int i32x4 __attribute__((ext_vector_type(4)));

constexpr int NB = 4, T = 4096, M = NB * T, D = 1024, INW = 5376;
constexpr int MEML = 256, XW = 512, DFF = 2816, NE = 8, DFE = 3584;
constexpr float EPS = 1e-6f;
constexpr float LOG2E = 1.4426950408889634f;
constexpr float QSCALE64 = 0.125f * LOG2E;
constexpr float QSCALE128 = 0.08838834764831845f * LOG2E;

typedef __bf16 bf16x2_t __attribute__((ext_vector_type(2)));
__device__ __forceinline__ unsigned cvt_pk_bf16(float lo, float hi) { f32x2 v = {lo, hi}; bf16x2_t b = __builtin_convertvector(v, bf16x2_t); return __builtin_bit_cast(unsigned, b); }
__device__ __forceinline__ float bf2f(unsigned short b) { return __uint_as_float((unsigned)b << 16); }
__device__ __forceinline__ float bflo(unsigned w) { return __uint_as_float(w << 16); }
__device__ __forceinline__ float bfhi(unsigned w) { return __uint_as_float(w & 0xffff0000u); }
__device__ __forceinline__ float fast_exp2(float x) { return __builtin_amdgcn_exp2f(x); }
__device__ __forceinline__ float fast_rcp(float x) { return __builtin_amdgcn_rcpf(x); }
__device__ __forceinline__ float sigmoidf_fast(float x) { return fast_rcp(1.0f + fast_exp2(-x * LOG2E)); }

constexpr float F8_WSCALE = 64.0f, F8_WINV = 1.0f / 64.0f;
__device__ __forceinline__ float f8clamp(float v) { return __builtin_amdgcn_fmed3f(v, -448.f, 448.f); }
__device__ __forceinline__ unsigned cvt_pk4_fp8(float a, float b, float c, float d) {
    int p = __builtin_amdgcn_cvt_pk_fp8_f32(f8clamp(a), f8clamp(b), 0, false); p = __builtin_amdgcn_cvt_pk_fp8_f32(f8clamp(c), f8clamp(d), p, true); return (unsigned)p; }
__device__ __forceinline__ void st16(void* p, u32x4 v) { *(GAS u32x4*)p = v; }
__device__ __forceinline__ void st16(void* p, f32x4 v) { *(GAS f32x4*)p = v; }
__device__ __forceinline__ void st8(void* p, u32x2 v) { *(GAS u32x2*)p = v; }

namespace pg8 {
constexpr int BM = 256, BK = 64, HALF = 128, HTB = HALF * BK * 2, STAGE_BYTES = 8 * HTB, NXCD = 8, WGM = 8;
__host__ __device__ __forceinline__ int lds_byte(int r, int c) { const int st = (r >> 4) * 2 + (c >> 5), rr = r & 15, cc = c & 31, ob = rr * 64 + cc * 2; return st * 1024 + (ob ^ (((ob >> 9) & 1) << 5)); }
__host__ __device__ __forceinline__ void stage_rc(int b, int& R, int& C) { const int st = b / 1024, sb = b % 1024, swz = sb ^ (((sb >> 9) & 1) << 5); R = (st >> 1) * 16 + swz / 64; C = (st & 1) * 32 + (swz % 64) / 2; }
__host__ __device__ __forceinline__ int perm32(int rho) { const int n = rho >> 4, i = rho & 15; return 8 * (i >> 2) + 4 * n + (i & 3); }

struct Unit { int pm, pn, pb, po; };
struct Gemm { const bf16* A; const bf16* Bt; int K; const int* rowmap; int lda = 0, ldb = 0; };

struct StaticOrder {
    int nM, nN, nwg, G, c;
    __device__ void init(int M_, int N_, int G_, int c_) { nM = M_ / BM; nN = N_ / BM; nwg = nM * nN; G = G_; c = c_; }
    __device__ __forceinline__ bool next_mn(int i, int& pm, int& pn) const { return next_L((long)i * G + c, pm, pn); }
    __device__ __forceinline__ bool next_L(long L, int& pm, int& pn) const {
        if (L >= nwg) return false;
        int wgid = (int)L; { const int q = nwg / NXCD, r = nwg % NXCD, xcd = wgid % NXCD, off = wgid / NXCD; wgid = (xcd < r ? xcd * (q + 1) : r * (q + 1) + (xcd - r) * q) + off; }
        const int nig = WGM * nN, gid = wgid / nig, fm = gid * WGM, gsz = (nM - fm) < WGM ? (nM - fm) : WGM;
        pm = fm + ((wgid % nig) % gsz); pn = (wgid % nig) / gsz; return true;
    }
    __device__ __forceinline__ bool next(int i, Unit& u) const { int pm, pn; if (!next_mn(i, pm, pn)) return false; u.pm = pm; u.pn = pn; u.pb = pn; u.po = pm; return true; }
};
template <bool UP> struct MoeOrder {
    StaticOrder so; int n0, rtA, rtB, hbase, nd; const int* tile_expert; int nNexp;
    __device__ void init(int ntiles, int N_, int G_, int c_, int n0_, int rtA_, int rtB_, int hbase_, int nd_, const int* te) { so.init(ntiles * BM, N_, G_, c_); n0 = n0_; rtA = rtA_; rtB = rtB_; hbase = hbase_; nd = nd_; tile_expert = te; nNexp = N_ / BM; }
    __device__ __forceinline__ bool next(int i, Unit& u) const {
        long L;
        if (nd == 0) L = (long)i * so.G + so.c;
        else { const int r = (so.c < nd) ? i + 3 : i; if (r < 3) L = (long)r * (so.G - nd) + (so.c - nd); else L = 3L * (so.G - nd) + (long)(r - 3) * so.G + so.c; }
        int pm, pn; if (!so.next_L(L, pm, pn)) return false;
        const int rt = pm < n0 ? rtA + pm : rtB + (pm - n0); const int e = __builtin_amdgcn_readfirstlane(tile_expert[rt]);
        u.pn = pn; u.pb = e * nNexp + pn; if (UP) { u.pm = rt; u.po = hbase + pm; } else { u.pm = hbase + pm; u.po = rt; } return true; }
};

template <class Epi, class Sched, bool GATHER = false, bool ALIGN_EPI = true, int MODE = 0>
__device__ __forceinline__ void gemm_phase(LAS unsigned char* lds, const int tid  , const Gemm g, const Sched& S, const Epi& E) {
    const int wid = __builtin_amdgcn_readfirstlane(tid >> 6), lane = tid & 63, wr = wid >> 2, wc = wid & 3, fr = lane & 15, fq = lane >> 4;
    constexpr bool F8 = (MODE == 1), I8 = (MODE == 2);
    constexpr int EB = MODE ? 1 : 2;
    const int K = g.K, nt = K / (MODE ? 2 * BK : BK), lda = (g.lda ? g.lda : K) * EB, ldb = (g.ldb ? g.ldb : K) * EB;
    unsigned voffA[2], voffB[2];
#pragma unroll
    for (int i = 0; i < 2; ++i) { int R, C; stage_rc(tid * 16 + i * 8192, R, C); const int Rb = Epi::PERM ? ((R & ~31) + perm32(R & 31)) : R; voffA[i] = (unsigned)(R * lda + C * 2); voffB[i] = (unsigned)(Rb * ldb + C * 2); }
    const size_t kstep = (size_t)(BK * 2);
    const size_t hstepA = (size_t)HALF * lda, hstep = (size_t)HALF * ldb;
    const size_t tstepA = 2 * hstepA, tstep = 2 * hstep;
    const unsigned ldsw = (unsigned)wid * 1024u;
    const int aoff = lds_byte(wr * 64 + fr, fq * 8), boff = lds_byte(wc * 32 + fr, fq * 8);
#define PG8_SA(b, h) (((b) * 2 + (h)) * HTB)
#define PG8_SB(b, h) ((4 + (b) * 2 + (h)) * HTB)
#define PG8_STAGE(bufoff, gbase, voff) do { _Pragma("unroll") for (int _i = 0; _i < 2; ++_i) \
        __builtin_amdgcn_global_load_lds((const unsigned*)((const char*)(gbase) + (voff)[_i]), (LAS unsigned*)(lds + (bufoff) + ldsw + _i * 8192), 16, 0, 0); } while (0)
#define PG8_LDA(dst, b, h) do { _Pragma("unroll") for (int m = 0; m < 4; ++m) { if constexpr (F8) { dst##8[m].lo = *(const LAS i32x4*)(lds + PG8_SA(b, h) + aoff + m * 2048); dst##8[m].hi = *(const LAS i32x4*)(lds + PG8_SA(b, h) + aoff + m * 2048 + 1024); } \
        else { _Pragma("unroll") for (int k = 0; k < 2; ++k) dst[m][k] = *(const LAS bf16x8*)(lds + PG8_SA(b, h) + aoff + m * 2048 + k * 1024); } } } while (0)
#define PG8_LDB(dst, b, h) do { _Pragma("unroll") for (int n = 0; n < 2; ++n) { if constexpr (F8) { dst##8[n].lo = *(const LAS i32x4*)(lds + PG8_SB(b, h) + boff + n * 2048); dst##8[n].hi = *(const LAS i32x4*)(lds + PG8_SB(b, h) + boff + n * 2048 + 1024); } \
        else { _Pragma("unroll") for (int k = 0; k < 2; ++k) dst[n][k] = *(const LAS bf16x8*)(lds + PG8_SB(b, h) + boff + n * 2048 + k * 1024); } } } while (0)
#define PG8_MMA(ai, bj, At, Bt) do { __builtin_amdgcn_s_setprio(1); _Pragma("unroll") for (int m = 0; m < 4; ++m) _Pragma("unroll") for (int n = 0; n < 2; ++n) { if constexpr (F8) \
        asm volatile("v_mfma_f32_16x16x128_f8f6f4 %0, %1, %2, %0" : "+v"(acc[ai][bj][m][n]) : "v"(Bt##8[n]), "v"(At##8[m])); else if constexpr (I8) { _Pragma("unroll") for (int k = 0; k < 2; ++k) \
        acc[ai][bj][m][n] = __builtin_bit_cast(f32x4, __builtin_amdgcn_mfma_i32_16x16x64_i8(__builtin_bit_cast(i32x4, Bt[n][k]), __builtin_bit_cast(i32x4, At[m][k]), __builtin_bit_cast(i32x4, acc[ai][bj][m][n]), 0, 0, 0)); } else { _Pragma("unroll") for (int k = 0; k < 2; ++k) \
        acc[ai][bj][m][n] = __builtin_amdgcn_mfma_f32_16x16x32_bf16(Bt[n][k], At[m][k], acc[ai][bj][m][n], 0, 0, 0); } } __builtin_amdgcn_s_setprio(0); } while (0)
#define PG8_WAIT_V(n) asm volatile("s_waitcnt vmcnt(" #n ")" ::: "memory")
#define PG8_WAIT_L(n) asm volatile("s_waitcnt lgkmcnt(" #n ")" ::: "memory")
#define PG8_BAR __builtin_amdgcn_s_barrier()
#define PG8_SCHED __builtin_amdgcn_sched_barrier(0)
    LAS int* rmL = (LAS int*)(lds + 131072 + 12288);
#define PG8_RMDMA(b, u) __builtin_amdgcn_global_load_lds((const unsigned*)(g.rowmap + (u).pm * BM + (wid & 3) * 64 + lane), (LAS unsigned*)(rmL + (b) * 256 + (wid & 3) * 64), 4, 0, 0)
#define PG8_GOFFS(vo, b) do { _Pragma("unroll") for (int _h = 0; _h < 2; ++_h) _Pragma("unroll") for (int _i = 0; _i < 2; ++_i) { int _R, _C; stage_rc(tid * 16 + _i * 8192, _R, _C); \
        const int _row = rmL[(b) * 256 + _h * HALF + _R]; vo[_h][_i] = (unsigned)(_row * lda + _C * 2); } } while (0)
#define PG8_STAGE_A(bufoff, p, h, nextu) do { if constexpr (GATHER) { if (nextu) PG8_STAGE(bufoff, p, voN[h]); else PG8_STAGE(bufoff, p, voC[h]); } else PG8_STAGE(bufoff, (p) + (h) * hstepA, voffA); } while (0)
    Unit cur, nxt; int ui = 0;
    if (!S.next(0, cur)) return;
    f32x4 acc[2][2][4][2];
#pragma unroll
    for (int a = 0; a < 2; ++a)
#pragma unroll
        for (int b = 0; b < 2; ++b)
#pragma unroll
            for (int m = 0; m < 4; ++m)
#pragma unroll
                for (int n = 0; n < 2; ++n) acc[a][b][m][n] = (f32x4){0.f, 0.f, 0.f, 0.f};
    bf16x8 At[4][2], B0[2][2], B1[2][2];
    i32x8 At8[4], B08[2], B18[2];
    unsigned voC[2][2], voN[2][2];
    if constexpr (GATHER) { PG8_RMDMA(0, cur); PG8_WAIT_V(0); PG8_BAR; PG8_GOFFS(voC, 0); }
    const char* cA = GATHER ? (const char*)g.A : (const char*)g.A + (size_t)cur.pm * tstepA; const char* cB = (const char*)g.Bt + (size_t)cur.pb * tstep;
    PG8_STAGE(PG8_SB(0, 0), cB, voffB); PG8_STAGE(PG8_SB(0, 1), cB + hstep, voffB); PG8_STAGE_A(PG8_SA(0, 0), cA, 0, false); PG8_STAGE_A(PG8_SA(0, 1), cA, 1, false);
    if (wr == 1) PG8_BAR;
    PG8_WAIT_V(2); PG8_BAR;
    PG8_STAGE(PG8_SB(1, 0), cB + kstep, voffB); PG8_STAGE_A(PG8_SA(1, 0), cA + kstep, 0, false); PG8_STAGE(PG8_SB(1, 1), cB + hstep + kstep, voffB);
    PG8_WAIT_V(6); PG8_BAR;
    for (;;) {
        const bool has_next = S.next(ui + 1, nxt);
        if constexpr (GATHER) { if (has_next) PG8_RMDMA((ui + 1) & 1, nxt); }
        const char* nA = GATHER ? cA : (has_next ? (const char*)g.A + (size_t)nxt.pm * tstepA : cA); const char* nB = has_next ? (const char*)g.Bt + (size_t)nxt.pb * tstep : cB;
#pragma clang loop unroll(disable)
        for (int t = 0; t < nt; t += 2) {
            const bool last = (t == nt - 2);
            if constexpr (GATHER) { if (last) { if (has_next) { PG8_GOFFS(voN, (ui + 1) & 1); } else {
#pragma unroll
                for (int _h = 0; _h < 2; ++_h)
#pragma unroll
                    for (int _i = 0; _i < 2; ++_i) voN[_h][_i] = voC[_h][_i]; } } }
            const char* a1 = cA + (size_t)(t + 1) * kstep;
            const char* a2 = last ? nA : cA + (size_t)(t + 2) * kstep; const char* b2 = last ? nB : cB + (size_t)(t + 2) * kstep;
            const char* a3 = a2 + kstep; const char* b3 = b2 + kstep;
            PG8_LDB(B0, 0, 0); PG8_LDB(B1, 0, 1); PG8_SCHED; PG8_LDA(At, 0, 0); PG8_STAGE_A(PG8_SA(1, 1), a1, 1, false);
            PG8_WAIT_V(8); PG8_WAIT_L(0); PG8_BAR; PG8_MMA(0, 0, At, B0); PG8_MMA(0, 1, At, B1); PG8_BAR; PG8_SCHED;
            PG8_LDA(At, 0, 1); PG8_STAGE(PG8_SB(0, 0), b2, voffB); PG8_STAGE(PG8_SB(0, 1), b2 + hstep, voffB); PG8_STAGE_A(PG8_SA(0, 0), a2, 0, last);
            PG8_WAIT_V(8); PG8_WAIT_L(0); PG8_BAR; PG8_MMA(1, 0, At, B0); PG8_MMA(1, 1, At, B1); PG8_BAR; PG8_SCHED;
            PG8_LDB(B0, 1, 0); PG8_LDB(B1, 1, 1); PG8_SCHED; PG8_LDA(At, 1, 0); PG8_STAGE_A(PG8_SA(0, 1), a2, 1, last);
            PG8_WAIT_V(8); PG8_WAIT_L(0); PG8_BAR; PG8_MMA(0, 0, At, B0); PG8_MMA(0, 1, At, B1); PG8_BAR; PG8_SCHED;
            PG8_LDA(At, 1, 1); PG8_STAGE(PG8_SB(1, 0), b3, voffB); PG8_STAGE(PG8_SB(1, 1), b3 + hstep, voffB); PG8_STAGE_A(PG8_SA(1, 0), a3, 0, last);
            PG8_WAIT_V(8); PG8_WAIT_L(0); PG8_BAR; PG8_MMA(1, 0, At, B0); PG8_MMA(1, 1, At, B1); PG8_BAR; PG8_SCHED;
            if constexpr (Epi::HAS_MID) { if (E.is_mid(t + 2)) E.mid(acc, cur, t + 2, wr, wc, fr, fq); }
        }
        if constexpr (ALIGN_EPI) { if (wr == 0) PG8_BAR; }
        if constexpr (F8) asm volatile("s_nop 15\n\ts_nop 15" ::: "memory");
        E(acc, cur, wr, wc, fr, fq);
        if (!has_next) break;
#pragma unroll
        for (int a = 0; a < 2; ++a)
#pragma unroll
            for (int b = 0; b < 2; ++b)
#pragma unroll
                for (int m = 0; m < 4; ++m)
#pragma unroll
                    for (int n = 0; n < 2; ++n) acc[a][b][m][n] = (f32x4){0.f, 0.f, 0.f, 0.f};
        cur = nxt; cA = nA; cB = nB; ++ui;
        if constexpr (GATHER) {
#pragma unroll
            for (int _h = 0; _h < 2; ++_h)
#pragma unroll
                for (int _i = 0; _i < 2; ++_i) voC[_h][_i] = voN[_h][_i]; }
        if constexpr (ALIGN_EPI) { if (wr == 1) PG8_BAR; }
    }
    PG8_WAIT_V(0);
    if constexpr (!ALIGN_EPI) { if (wr == 0) PG8_BAR; }
    PG8_BAR;
#undef PG8_GOFFS
#undef PG8_RMDMA
#undef PG8_STAGE_A
#undef PG8_SA
#undef PG8_SB
#undef PG8_STAGE
#undef PG8_LDA
#undef PG8_LDB
#undef PG8_MMA
#undef PG8_WAIT_V
#undef PG8_WAIT_L
#undef PG8_BAR
#undef PG8_SCHED
}
}
constexpr size_t MiB = 1u << 20;
constexpr size_t WS_CTL = 0, CTL_ZERO_BYTES = 1 * MiB;
constexpr size_t CTL_CMAX_XKV = 155648;
constexpr size_t CTL_CMAX_IN = 98304;
constexpr size_t CTL_CMAX = 65536;
constexpr size_t WS_ROPE = 1 * MiB;
constexpr size_t WS_KMEAN = 2 * MiB;
constexpr size_t WS_ROUTE = 3 * MiB;
constexpr size_t RT_TOKE = 0, RT_TOKW = 128 * 1024, RT_SLOT = 256 * 1024, RT_ROWMAP = 384 * 1024, RT_META = 640 * 1024, RT_RTOK = 704 * 1024  , RT_RSLOT = 768 * 1024  ;
constexpr size_t WS_W = 4 * MiB;
constexpr size_t WL_IN = 0, WL_PA = 10752 * 1024, WL_PB = WL_PA + 512 * 1024, WL_PC = WL_PB + 1024 * 1024, WL_MIX = WL_PC + 512 * 1024,
                 WL_XQ = WL_MIX + 2 * MiB, WL_XKV = WL_XQ + 1 * MiB, WL_XO = WL_XKV + 2 * MiB, WL_SIZE = WL_XO + 1 * MiB;
static_assert(WL_SIZE == 18944 * 1024, "layer weight block");
constexpr size_t WS_FFN_GU = WS_W + 2 * WL_SIZE;
constexpr size_t WS_FFN_DN = WS_FFN_GU + 11 * MiB;
constexpr size_t WS_MOE_GU = 58 * MiB;
constexpr size_t WS_XN8 = 114 * MiB;
constexpr size_t WL_IN_G8 = 4608 * 1024;
constexpr size_t WS_MOE_DN = 170 * MiB;
constexpr size_t WS_MEMN = 226 * MiB;
constexpr size_t WS_KX = 230 * MiB;
constexpr size_t WS_VTX = 232 * MiB;
constexpr size_t WS_XN = 236 * MiB;
constexpr size_t WS_HEADS = 268 * MiB;
constexpr size_t HD_QA = 0, HD_KA = 8 * MiB, HD_VTA = 16 * MiB, HD_QB = 24 * MiB, HD_KB = 40 * MiB, HD_VTB = 44 * MiB, HD_QC = 48 * MiB, HD_KC = 56 * MiB, HD_VTC = 64 * MiB;
constexpr size_t WS_G = 340 * MiB;
constexpr size_t WS_QX = WS_G, WS_OX = WS_G + 16 * MiB;
constexpr size_t WS_O = 436 * MiB;
constexpr int O_A = 0, O_B = 256, O_C = 768;
constexpr size_t WS_UBF = WS_XN;
constexpr size_t WS_XRES = 468 * MiB;
constexpr int HFFN_LD = DFF + 64;
constexpr size_t WS_HFFN = WS_HEADS;
constexpr size_t WS_HMOE = WS_HEADS;
constexpr size_t WS_Y = 396 * MiB;
constexpr size_t WS_END = 500 * MiB;
static_assert( WS_HMOE + (size_t)73 * 256 * DFE * 2 <= WS_Y && WS_Y + (size_t)34816 * D * 2 <= WS_XRES && WS_HFFN + (size_t)M * HFFN_LD * 2 <= WS_OX + 16 * MiB && WS_FFN_DN + (size_t)D * HFFN_LD * 2 <= WS_MOE_GU, "ws map");
constexpr int MOE_MAX_RT = 136, MOE_CHUNK_RT = 64, MOE_X = 9;

constexpr int RING_BYTES = 131072, LDS_BYTES = 147456, MISC_OFF = LDS_BYTES - 256;
constexpr int NWAVES = 8;

#define XB_TMO      128
#define XB_XCNT(j)  (256  + 64 * (j))
#define XB_XSUB(j)  (1280 + 64 * (j))
#define XB_XGEN(j)  (2304 + 64 * (j))
#define XB_TOP      3328
#define XB_TOPGEN   3392
#define XCD_BAR_WORDS 3456
#define XB_SPIN_CAP (1u << 18)
__device__ __forceinline__ unsigned xb_ld(unsigned* p)              { return __hip_atomic_load(p, __ATOMIC_RELAXED, __HIP_MEMORY_SCOPE_AGENT); }
__device__ __forceinline__ unsigned xb_add(unsigned* p, unsigned v) { return __hip_atomic_fetch_add(p, v, __ATOMIC_RELAXED, __HIP_MEMORY_SCOPE_AGENT); }
__device__ __forceinline__ unsigned xb_xcc_id() { return (unsigned)__builtin_amdgcn_s_getreg((3 << 11) | 20) & 0xFu; }
#define XB_SPIN(cond, bar) do { unsigned _sp = 0; while (cond) { __builtin_amdgcn_s_sleep(1); \
    if ((++_sp & 255u) == 0u) { if (xb_ld(&(bar)[XB_TMO])) break; if (_sp > XB_SPIN_CAP) { atomicAdd(&(bar)[XB_TMO], 1u); break; } } } } while (0)
struct XcdBarrier { unsigned* bar; unsigned x; volatile LAS unsigned* st; };
__device__ __forceinline__ XcdBarrier xcd_barrier_post(unsigned* bar, volatile LAS unsigned* st, int tid) {
    XcdBarrier b; b.bar = bar; b.x = xb_xcc_id(); b.st = st;
    if (tid == 0) (void)xb_add(&bar[XB_XCNT(b.x)], 1u);
    return b;
}
__device__ __forceinline__ void xcd_barrier_complete(unsigned* bar, unsigned x, unsigned& nloc, unsigned& nx) {
    const unsigned G = gridDim.x * gridDim.y * gridDim.z;
    unsigned sum, cnt, mine, sp = 0u;
    for (;;) {
        sum = 0u; cnt = 0u; mine = 0u;
#pragma unroll
        for (unsigned j = 0; j < 16; ++j) { const unsigned c = xb_ld(&bar[XB_XCNT(j)]); sum += c; cnt += (c > 0u) ? 1u : 0u; mine = (j == x) ? c : mine; }
        if (sum == G) break;
        __builtin_amdgcn_s_sleep(1);
        if ((++sp & 255u) == 0u) { if (xb_ld(&bar[XB_TMO])) break; if (sp > XB_SPIN_CAP) { atomicAdd(&bar[XB_TMO], 1u); break; } }
    }
    nloc = mine > 0u ? mine : 1u; nx = cnt > 0u ? cnt : 1u;
}
__device__ __forceinline__ void xcd_barrier(const XcdBarrier& b, int tid  ) {
    asm volatile("s_waitcnt vmcnt(0)" ::: "memory");
    __syncthreads();
    if (tid == 0) {
        unsigned* bar = b.bar;
        __builtin_amdgcn_s_waitcnt(0);
        unsigned nloc = b.st[0], nx = b.st[1];
        if (nloc == 0u) { xcd_barrier_complete(bar, b.x, nloc, nx); b.st[0] = nloc; b.st[1] = nx; }
        const unsigned old = xb_add(&bar[XB_XSUB(b.x)], 1u);
        const unsigned gen = old / nloc;
        if (old + 1u == (gen + 1u) * nloc) {
            __builtin_amdgcn_fence(__ATOMIC_RELEASE, "agent");
            asm volatile("s_waitcnt vmcnt(0)" ::: "memory");
            const unsigned og = xb_add(&bar[XB_TOP], 1u);
            const unsigned tg = og / nx;
            if (og + 1u == (tg + 1u) * nx) xb_add(&bar[XB_TOPGEN], 1u);
            else XB_SPIN(xb_ld(&bar[XB_TOPGEN]) == tg, bar);
            __builtin_amdgcn_fence(__ATOMIC_ACQUIRE, "agent");
            xb_add(&bar[XB_XGEN(b.x)], 1u);
            asm volatile("s_waitcnt vmcnt(0)" ::: "memory");
        } else {
            XB_SPIN(xb_ld(&bar[XB_XGEN(b.x)]) == gen, bar);
            __builtin_amdgcn_fence(__ATOMIC_ACQUIRE, "agent");
            asm volatile("s_waitcnt vmcnt(0)" ::: "memory");
        }
    }
    __syncthreads();
}

using pg8::Unit;
__device__ __forceinline__ int pi32c(int r) { return (r & ~12) | ((r & 4) << 1) | ((r & 8) >> 1); }
template <bool I8> __device__ __forceinline__ f32x4 acc_val(const f32x4& a, const f32x4& cs, float rsv) {
    if constexpr (I8) return (f32x4){(float)__float_as_int(a[0]), (float)__float_as_int(a[1]), (float)__float_as_int(a[2]), (float)__float_as_int(a[3])} * (cs * rsv); else return a; }
template <bool I8> struct EpiInprojT {
    static constexpr bool PERM = true, HAS_MID = false;
    unsigned char* ws; const float* ropec; const float* ropes; LAS unsigned char* ldsx;
    const float* rs = nullptr; const unsigned* cmax = nullptr;
    __device__ __forceinline__ void operator()(const f32x4 (&acc)[2][2][4][2], const Unit& u, int wr, int wc, int fr, int fq) const {
        const int row0 = u.po * 256 + wr * 64 + fr;
        const int pn = u.pn;
        f32x4 cs[2][2];
#pragma unroll
        for (int bj = 0; bj < 2; ++bj)
#pragma unroll
            for (int n = 0; n < 2; ++n) { if constexpr (I8) { const u32x4 c4 = *(const u32x4*)(cmax + pn * 256 + bj * 128 + wc * 32 + 8 * fq + 4 * n);
                cs[bj][n] = (f32x4){__uint_as_float(c4.x), __uint_as_float(c4.y), __uint_as_float(c4.z), __uint_as_float(c4.w)} * (1.0f / 127.0f); } else cs[bj][n] = (f32x4){1.f, 1.f, 1.f, 1.f}; }
        float rsr[2][4];
#pragma unroll
        for (int ai = 0; ai < 2; ++ai)
#pragma unroll
            for (int m = 0; m < 4; ++m) rsr[ai][m] = I8 ? rs[row0 + ai * 128 + m * 16] : 1.f;
        if (pn >= 9) {
            bf16* G = (bf16*)(ws + WS_G);
            const int col0 = (pn - 9) * 256 + wc * 32 + 8 * fq;
            for (int rp = 0; rp < REPS(19); ++rp) { asm volatile("" ::: "memory");
#pragma unroll
            for (int ai = 0; ai < 2; ++ai)
#pragma unroll
                for (int m = 0; m < 4; ++m) { bf16* rowp = G + (size_t)(row0 + ai * 128 + m * 16) * 3072 + col0; const float rsv = rsr[ai][m];
#pragma unroll
                    for (int bj = 0; bj < 2; ++bj) { const f32x4 v0 = acc_val<I8>(acc[ai][bj][m][0], cs[bj][0], rsv), v1 = acc_val<I8>(acc[ai][bj][m][1], cs[bj][1], rsv); u32x4 w;
                        w.x = cvt_pk_bf16(sigmoidf_fast(v0[0]), sigmoidf_fast(v0[1])); w.y = cvt_pk_bf16(sigmoidf_fast(v0[2]), sigmoidf_fast(v0[3]));
                        w.z = cvt_pk_bf16(sigmoidf_fast(v1[0]), sigmoidf_fast(v1[1])); w.w = cvt_pk_bf16(sigmoidf_fast(v1[2]), sigmoidf_fast(v1[3]));
                        st16(rowp + bj * 128, w); } } }
            return;
        }
        int kind = 0  , H = 4, head = wc; bool rope = false; float sc = 1.f; size_t off = 0;
        switch (pn) {
            case 0: off = HD_QA; rope = true; sc = QSCALE64; break;
            case 1: off = HD_KA; rope = true; break;
            case 2: off = HD_VTA; kind = 1; break;
            case 3: off = HD_QB; H = 8; rope = true; sc = QSCALE64; break;
            case 4: off = HD_QB; H = 8; head = 4 + wc; rope = true; sc = QSCALE64; break;
            case 5: H = 2; if (wc < 2) { off = HD_KB; rope = true; } else { off = HD_VTB; kind = 1; head = wc - 2; } break;
            case 6: off = HD_QC; sc = QSCALE64; break;
            case 7: off = HD_KC; break;
            default: off = HD_VTC; kind = 1; break;
        }
        bf16* base = (bf16*)(ws + WS_HEADS + off);
        const int b = (u.po * 256) / T;
        const int tb = (u.po * 256) % T + wr * 64 + fr;
        if (kind == 0) { for (int rp = 0; rp < REPS(18); ++rp) { asm volatile("" ::: "memory");
            bf16* hb = base + ((size_t)(b * H + head) * T) * 64 + 8 * fq;
            const bool isk = (pn == 1) || (pn == 5) || (pn == 7);
            bf16* kbase = base + ((size_t)(b * H + head) * T) * 64;
            f32x4 rcb[1][4];
#define EI_LDROPE(buf, tt) do { rcb[buf][0] = *(const f32x4*)(ropec + (tt) * 32 + 8 * fq); rcb[buf][1] = *(const f32x4*)(ropec + (tt) * 32 + 8 * fq + 4); rcb[buf][2] = *(const f32x4*)(ropes + (tt) * 32 + 8 * fq); rcb[buf][3] = *(const f32x4*)(ropes + (tt) * 32 + 8 * fq + 4); } while (0)
            EI_LDROPE(0, tb);
#pragma unroll
            for (int it = 0; it < 8; ++it) { const int ai = it >> 2, m = it & 3; const int t = tb + ai * 128 + m * 16; const float rsv = rsr[ai][m];
                    f32x4 x1a = acc_val<I8>(acc[ai][0][m][0], cs[0][0], rsv), x1b = acc_val<I8>(acc[ai][0][m][1], cs[0][1], rsv), x2a = acc_val<I8>(acc[ai][1][m][0], cs[1][0], rsv), x2b = acc_val<I8>(acc[ai][1][m][1], cs[1][1], rsv);
                    if (rope) { const f32x4 ca = rcb[0][0], cb = rcb[0][1];
                        const f32x4 sa = rcb[0][2], sb = rcb[0][3];
                        const f32x4 y1a = x1a * ca - x2a * sa, y2a = x2a * ca + x1a * sa, y1b = x1b * cb - x2b * sb, y2b = x2b * cb + x1b * sb;
                        x1a = y1a; x2a = y2a; x1b = y1b; x2b = y2b; }
                    asm volatile("" ::: "memory");
                    if (it + 1 < 8) EI_LDROPE(0, tb + ((it + 1) >> 2) * 128 + ((it + 1) & 3) * 16);
                    x1a = x1a * sc; x1b = x1b * sc; x2a = x2a * sc; x2b = x2b * sc;
                    u32x4 w1, w2; w1.x = cvt_pk_bf16(x1a[0], x1a[1]); w1.y = cvt_pk_bf16(x1a[2], x1a[3]); w1.z = cvt_pk_bf16(x1b[0], x1b[1]); w1.w = cvt_pk_bf16(x1b[2], x1b[3]);
                    w2.x = cvt_pk_bf16(x2a[0], x2a[1]); w2.y = cvt_pk_bf16(x2a[2], x2a[3]); w2.z = cvt_pk_bf16(x2b[0], x2b[1]); w2.w = cvt_pk_bf16(x2b[2], x2b[3]);
                    if (isk) { bf16* kp = kbase + ((size_t)(t >> 5) * 8 + (fq & 1)) * 256 + (size_t)pi32c(t & 31) * 8 + (size_t)(fq >> 1) * 512;
                        st16(kp, w1); st16(kp + 1024, w2); }
                    else { bf16* rp = hb + (size_t)t * 64; st16(rp, w1); st16(rp + 32, w2); } }
#undef EI_LDROPE
        } } else { for (int rp = 0; rp < REPS(20); ++rp) { asm volatile("" ::: "memory");
            bf16* vb2 = base + (size_t)(b * H + head) * 64 * T;
            LAS bf16* tr = (LAS bf16*)(ldsx + (wr * 4 + wc) * 1024);
            const int ln = fq * 16 + fr, dd = ln >> 1, th = ln & 1;
#pragma unroll
            for (int ai = 0; ai < 2; ++ai)
#pragma unroll
                for (int m = 0; m < 4; ++m) { const int t16 = (u.po * 256) % T + wr * 64 + ai * 128 + m * 16;
                    const float rsv = rsr[ai][m];
#pragma unroll
                    for (int bj = 0; bj < 2; ++bj) {
#pragma unroll
                        for (int n = 0; n < 2; ++n) { const f32x4 av = acc_val<I8>(acc[ai][bj][m][n], cs[bj][n], rsv);
#pragma unroll
                            for (int e = 0; e < 4; e += 2) { const unsigned w = cvt_pk_bf16(av[e], av[e + 1]);
                                tr[(8 * fq + 4 * n + e) * 16 + fr] = (bf16)(w & 0xffffu); tr[(8 * fq + 4 * n + e + 1) * 16 + fr] = (bf16)(w >> 16); } }
                        const u32x4 v = *(const LAS u32x4*)(tr + dd * 16 + 8 * th);
                        const int t8 = t16 + 8 * th;
                        *(u32x4*)(vb2 + ((size_t)(((t8 >> 5) * 2 + bj) * 4 + ((t8 >> 3) & 3)) * 32 + dd) * 8) = v; } }
        } }
    }
};
using EpiInproj = EpiInprojT<false>;
struct EpiGates8 {
    static constexpr bool PERM = true, HAS_MID = false;
    unsigned char* ws;
    __device__ __forceinline__ void operator()(const f32x4 (&acc)[2][2][4][2], const Unit& u, int wr, int wc, int fr, int fq) const {
        bf16* G = (bf16*)(ws + WS_G);
        const int row0 = u.po * 256 + wr * 64 + fr, col0 = u.pn * 256 + wc * 32 + 8 * fq;
#pragma unroll
        for (int ai = 0; ai < 2; ++ai)
#pragma unroll
            for (int m = 0; m < 4; ++m) { bf16* rowp = G + (size_t)(row0 + ai * 128 + m * 16) * 3072 + col0;
#pragma unroll
                for (int bj = 0; bj < 2; ++bj) { const f32x4 v0 = acc[ai][bj][m][0] * F8_WINV, v1 = acc[ai][bj][m][1] * F8_WINV; u32x4 w;
                    w.x = cvt_pk_bf16(sigmoidf_fast(v0[0]), sigmoidf_fast(v0[1])); w.y = cvt_pk_bf16(sigmoidf_fast(v0[2]), sigmoidf_fast(v0[3]));
                    w.z = cvt_pk_bf16(sigmoidf_fast(v1[0]), sigmoidf_fast(v1[1])); w.w = cvt_pk_bf16(sigmoidf_fast(v1[2]), sigmoidf_fast(v1[3]));
                    st16(rowp + bj * 128, w); } }
    }
};
struct GateOrder {
    pg8::StaticOrder so; int nskip;
    __device__ void init(int G_, int c_, int nskip_) { so.init(M, 3072, G_, c_); nskip = nskip_; }
    __device__ __forceinline__ bool next(int i, Unit& u) const {
        long L; const int r = (so.c < nskip) ? i + 2 : i;
        if (r < 2) L = (long)r * (so.G - nskip) + (so.c - nskip); else L = 2L * (so.G - nskip) + (long)(r - 2) * so.G + so.c;
        int pm, pn; if (!so.next_L(L, pm, pn)) return false; u.pm = pm; u.pn = pn; u.pb = pn; u.po = pm; return true; }
};
struct EpiKvMem {
    static constexpr bool PERM = true, HAS_MID = false;
    unsigned char* ws; const float* rs = nullptr; const unsigned* cmax = nullptr;
    __device__ __forceinline__ void operator()(const f32x4 (&acc)[2][2][4][2], const Unit& u, int wr, int wc, int fr, int fq) const {
        const int lb = u.po;
        const int pn = u.pn & 3;
        const int j0 = wr * 64 + fr;
        constexpr bool I8 = (KV_I8 != 0);
        f32x4 cs[2][2]; float rsr[2][4];
#pragma unroll
        for (int bj = 0; bj < 2; ++bj)
#pragma unroll
            for (int n = 0; n < 2; ++n) { if constexpr (I8) { const u32x4 c4 = *(const u32x4*)(cmax + (lb >> 2) * 1024 + pn * 256 + bj * 128 + wc * 32 + 8 * fq + 4 * n);
                cs[bj][n] = (f32x4){__uint_as_float(c4.x), __uint_as_float(c4.y), __uint_as_float(c4.z), __uint_as_float(c4.w)} * (1.0f / 127.0f); } else cs[bj][n] = (f32x4){1.f, 1.f, 1.f, 1.f}; }
#pragma unroll
        for (int ai = 0; ai < 2; ++ai)
#pragma unroll
            for (int m = 0; m < 4; ++m) rsr[ai][m] = I8 ? rs[lb * 256 + j0 + ai * 128 + m * 16] : 1.f;
        if (pn < 2) {
            bf16* kx = (bf16*)(ws + WS_KX);
#pragma unroll
            for (int ai = 0; ai < 2; ++ai)
#pragma unroll
                for (int m = 0; m < 4; ++m) { const int j = j0 + ai * 128 + m * 16;
#pragma unroll
                    for (int bj = 0; bj < 2; ++bj) { const int head = 2 * pn + bj, d = wc * 32 + 8 * fq; const f32x4 v0 = acc_val<I8>(acc[ai][bj][m][0], cs[bj][0], rsr[ai][m]), v1 = acc_val<I8>(acc[ai][bj][m][1], cs[bj][1], rsr[ai][m]); u32x4 w;
                        w.x = cvt_pk_bf16(v0[0], v0[1]); w.y = cvt_pk_bf16(v0[2], v0[3]); w.z = cvt_pk_bf16(v1[0], v1[1]); w.w = cvt_pk_bf16(v1[2], v1[3]);
                        *(u32x4*)(kx + (size_t)(lb * 4 + head) * 256 * 128 + ((size_t)((j >> 5) * 8 + (d >> 4)) * 2 + ((d >> 3) & 1)) * 256 + (size_t)pi32c(j & 31) * 8) = w; } }
        } else {
            bf16* vx = (bf16*)(ws + WS_VTX);
#pragma unroll
            for (int ai = 0; ai < 2; ++ai)
#pragma unroll
                for (int m = 0; m < 4; ++m) { const int j = j0 + ai * 128 + m * 16;
#pragma unroll
                    for (int bj = 0; bj < 2; ++bj) { const int head = 2 * (pn - 2) + bj;
#pragma unroll
                        for (int n = 0; n < 2; ++n) { const f32x4 av = acc_val<I8>(acc[ai][bj][m][n], cs[bj][n], rsr[ai][m]);
#pragma unroll
                            for (int e = 0; e < 4; e += 2) { const int d = wc * 32 + 8 * fq + 4 * n + e; const unsigned w = cvt_pk_bf16(av[e], av[e + 1]);
                                bf16* p = vx + (size_t)(lb * 4 + head) * 128 * 256 + ((size_t)(((j >> 5) * 4 + (d >> 5)) * 4 + ((j >> 3) & 3)) * 32 + (d & 31)) * 8 + (j & 7); p[0] = (bf16)(w & 0xffffu); p[8] = (bf16)(w >> 16); } } } }
        }
    }
};
struct EpiGateMix {
    static constexpr bool PERM = false, HAS_MID = true;
    const bf16* G; bf16* UBF;
    __device__ __forceinline__ bool is_mid(int t) const { return t == 4 || t == 12; }
    __device__ __forceinline__ void mid(f32x4 (&acc)[2][2][4][2], const Unit& u, int t, int wr, int wc, int fr, int fq) const {
        const int row0 = u.po * 256 + wr * 64 + fr, col0 = u.pn * 256 + wc * 32 + 4 * fq + (t == 4 ? 0 : 1024);
#pragma unroll
        for (int ai = 0; ai < 2; ++ai)
#pragma unroll
            for (int m = 0; m < 4; ++m) { const bf16* gr = G + (size_t)(row0 + ai * 128 + m * 16) * 3072 + col0;
#pragma unroll
                for (int bj = 0; bj < 2; ++bj)
#pragma unroll
                    for (int n = 0; n < 2; ++n) { const u32x2 gn = *(const u32x2*)(gr + bj * 128 + n * 16), gd = *(const u32x2*)(gr + bj * 128 + n * 16 + 1024);
                        f32x4 v = acc[ai][bj][m][n];
                        v[0] *= bflo(gn.x) * fast_rcp(fmaxf(bflo(gd.x), 1e-6f)); v[1] *= bfhi(gn.x) * fast_rcp(fmaxf(bfhi(gd.x), 1e-6f));
                        v[2] *= bflo(gn.y) * fast_rcp(fmaxf(bflo(gd.y), 1e-6f)); v[3] *= bfhi(gn.y) * fast_rcp(fmaxf(bfhi(gd.y), 1e-6f));
                        acc[ai][bj][m][n] = v; } }
    }
    __device__ __forceinline__ void operator()(const f32x4 (&acc)[2][2][4][2], const Unit& u, int wr, int wc, int fr, int fq) const {
        const int row0 = u.po * 256 + wr * 64 + fr, col0 = u.pn * 256 + wc * 32 + 4 * fq;
#pragma unroll
        for (int aim = 0; aim < 4; ++aim) { const int ai = aim >> 1;
            u32x2 gwb[4][2][2];
#pragma unroll
            for (int m = 2 * (aim & 1); m < 2 * (aim & 1) + 2; ++m)
#pragma unroll
                for (int bj = 0; bj < 2; ++bj)
#pragma unroll
                    for (int n = 0; n < 2; ++n) gwb[m][bj][n] = *(const u32x2*)(G + (size_t)(row0 + ai * 128 + m * 16) * 3072 + 2048 + col0 + bj * 128 + n * 16);
#pragma unroll
            for (int m = 2 * (aim & 1); m < 2 * (aim & 1) + 2; ++m) { const size_t r = (size_t)(row0 + ai * 128 + m * 16);
#pragma unroll
                for (int bj = 0; bj < 2; ++bj)
#pragma unroll
                    for (int n = 0; n < 2; ++n) { const int c = col0 + bj * 128 + n * 16; const u32x2 gw = gwb[m][bj][n];
                        const f32x4 v = acc[ai][bj][m][n]; u32x2 w;
                        w.x = cvt_pk_bf16(v[0] * fmaxf(bflo(gw.x), 1e-6f), v[1] * fmaxf(bfhi(gw.x), 1e-6f)); w.y = cvt_pk_bf16(v[2] * fmaxf(bflo(gw.y), 1e-6f), v[3] * fmaxf(bfhi(gw.y), 1e-6f));
                        st8(UBF + r * D + c, w); } } }
    }
};
template <bool FIRST> struct EpiResid {
    static constexpr bool PERM = true, HAS_MID = false;
    const float* x0; const bf16* XR; bf16* XO;
    __device__ __forceinline__ void operator()(const f32x4 (&acc)[2][2][4][2], const Unit& u, int wr, int wc, int fr, int fq) const {
        const int row0 = u.po * 256 + wr * 64 + fr, col0 = u.pn * 256 + wc * 32 + 8 * fq;
#pragma unroll
        for (int ai = 0; ai < 2; ++ai) {
            f32x4 pre[4][2][2];
#pragma unroll
            for (int m = 0; m < 4; ++m) { const size_t r = (size_t)(row0 + ai * 128 + m * 16) * D + col0;
#pragma unroll
                for (int bj = 0; bj < 2; ++bj) {
                    if (FIRST) { pre[m][bj][0] = *(const f32x4*)(x0 + r + bj * 128); pre[m][bj][1] = *(const f32x4*)(x0 + r + bj * 128 + 4); }
                    else { const u32x4 w = *(const u32x4*)(XR + r + bj * 128); pre[m][bj][0] = (f32x4){bflo(w.x), bfhi(w.x), bflo(w.y), bfhi(w.y)}; pre[m][bj][1] = (f32x4){bflo(w.z), bfhi(w.z), bflo(w.w), bfhi(w.w)}; } } }
#pragma unroll
            for (int m = 0; m < 4; ++m) { const size_t r = (size_t)(row0 + ai * 128 + m * 16) * D + col0;
#pragma unroll
                for (int bj = 0; bj < 2; ++bj) { const f32x4 v0 = pre[m][bj][0] + acc[ai][bj][m][0], v1 = pre[m][bj][1] + acc[ai][bj][m][1]; u32x4 w;
                    w.x = cvt_pk_bf16(v0[0], v0[1]); w.y = cvt_pk_bf16(v0[2], v0[3]); w.z = cvt_pk_bf16(v1[0], v1[1]); w.w = cvt_pk_bf16(v1[2], v1[3]);
                    st16(XO + r + bj * 128, w); } }
        }
    }
};
struct EpiXq {
    static constexpr bool PERM = true, HAS_MID = false;
    bf16* QX; float osc;
    __device__ __forceinline__ void operator()(const f32x4 (&acc)[2][2][4][2], const Unit& u, int wr, int wc, int fr, int fq) const {
        const int b = (u.po * 256) / T, tb = (u.po * 256) % T + wr * 64 + fr;
#pragma unroll
        for (int ai = 0; ai < 2; ++ai)
#pragma unroll
            for (int m = 0; m < 4; ++m) { const int t = tb + ai * 128 + m * 16; const float rn = osc;
#pragma unroll
                for (int bj = 0; bj < 2; ++bj) { const int head = 2 * u.pn + bj; const f32x4 v0 = acc[ai][bj][m][0] * rn, v1 = acc[ai][bj][m][1] * rn; u32x4 w;
                    w.x = cvt_pk_bf16(v0[0], v0[1]); w.y = cvt_pk_bf16(v0[2], v0[3]); w.z = cvt_pk_bf16(v1[0], v1[1]); w.w = cvt_pk_bf16(v1[2], v1[3]);
                    st16(QX + ((size_t)(b * 4 + head) * T + t) * 128 + wc * 32 + 8 * fq, w); } }
    }
};
struct EpiSwiglu {
    static constexpr bool PERM = true, HAS_MID = false;
    bf16* Hd; int ldh;
    __device__ __forceinline__ void operator()(const f32x4 (&acc)[2][2][4][2], const Unit& u, int wr, int wc, int fr, int fq) const {
        const int row0 = u.po * 256 + wr * 64 + fr, col0 = u.pn * 128 + wc * 32 + 8 * fq;
#pragma unroll
        for (int ai = 0; ai < 2; ++ai)
#pragma unroll
            for (int m = 0; m < 4; ++m) { float h[8];
#pragma unroll
                for (int n = 0; n < 2; ++n)
#pragma unroll
                    for (int e = 0; e < 4; ++e) { const float gt = acc[ai][0][m][n][e], up = acc[ai][1][m][n][e]; h[4 * n + e] = gt * sigmoidf_fast(gt) * up; }
                u32x4 w; w.x = cvt_pk_bf16(h[0], h[1]); w.y = cvt_pk_bf16(h[2], h[3]); w.z = cvt_pk_bf16(h[4], h[5]); w.w = cvt_pk_bf16(h[6], h[7]);
                st16(Hd + (size_t)(row0 + ai * 128 + m * 16) * ldh + col0, w); }
    }
};
struct EpiSwigluI8 {
    static constexpr bool PERM = true, HAS_MID = false;
    bf16* Hd; int ldh; const float* rs; const unsigned* cmax;
    __device__ __forceinline__ void operator()(const f32x4 (&acc)[2][2][4][2], const Unit& u, int wr, int wc, int fr, int fq) const {
        const int row0 = u.po * 256 + wr * 64 + fr, col0 = u.pn * 128 + wc * 32 + 8 * fq;
        float cg[8], cu[8];
        { const unsigned* cp = cmax + u.pn * 256 + wc * 32 + 8 * fq; const u32x4 g0 = *(const u32x4*)cp, g1 = *(const u32x4*)(cp + 4), u0 = *(const u32x4*)(cp + 128), u1 = *(const u32x4*)(cp + 132);
#pragma unroll
          for (int e = 0; e < 4; ++e) { cg[e] = __uint_as_float(g0[e]) * (1.0f / 127.0f); cg[4 + e] = __uint_as_float(g1[e]) * (1.0f / 127.0f); cu[e] = __uint_as_float(u0[e]) * (1.0f / 127.0f); cu[4 + e] = __uint_as_float(u1[e]) * (1.0f / 127.0f); } }
        float rsr[2][4];
#pragma unroll
        for (int ai = 0; ai < 2; ++ai)
#pragma unroll
            for (int m = 0; m < 4; ++m) rsr[ai][m] = rs[row0 + ai * 128 + m * 16];
#pragma unroll
        for (int ai = 0; ai < 2; ++ai)
#pragma unroll
            for (int m = 0; m < 4; ++m) { float h[8]; const float rsv = rsr[ai][m];
#pragma unroll
                for (int n = 0; n < 2; ++n)
#pragma unroll
                    for (int e = 0; e < 4; ++e) { const float gt = (float)__float_as_int(acc[ai][0][m][n][e]) * (rsv * cg[4 * n + e]), up = (float)__float_as_int(acc[ai][1][m][n][e]) * (rsv * cu[4 * n + e]); h[4 * n + e] = gt * sigmoidf_fast(gt) * up; }
                u32x4 w; w.x = cvt_pk_bf16(h[0], h[1]); w.y = cvt_pk_bf16(h[2], h[3]); w.z = cvt_pk_bf16(h[4], h[5]); w.w = cvt_pk_bf16(h[6], h[7]);
                st16(Hd + (size_t)(row0 + ai * 128 + m * 16) * ldh + col0, w); }
    }
};
struct EpiSwiglu8 {
    static constexpr bool PERM = true, HAS_MID = false;
    unsigned char* Hd; int ldh;
    __device__ __forceinline__ void operator()(const f32x4 (&acc)[2][2][4][2], const Unit& u, int wr, int wc, int fr, int fq) const {
        const int row0 = u.po * 256 + wr * 64 + fr, col0 = u.pn * 128 + wc * 32 + 8 * fq;
#pragma unroll
        for (int ai = 0; ai < 2; ++ai)
#pragma unroll
            for (int m = 0; m < 4; ++m) { float h[8];
#pragma unroll
                for (int n = 0; n < 2; ++n)
#pragma unroll
                    for (int e = 0; e < 4; ++e) { const float gt = acc[ai][0][m][n][e] * F8_WINV, up = acc[ai][1][m][n][e] * F8_WINV; h[4 * n + e] = gt * sigmoidf_fast(gt) * up; }
                u32x2 w; w.x = cvt_pk4_fp8(h[0], h[1], h[2], h[3]); w.y = cvt_pk4_fp8(h[4], h[5], h[6], h[7]);
                st8(Hd + (size_t)(row0 + ai * 128 + m * 16) * ldh + col0, w); }
    }
};
struct EpiBf16Out {
    static constexpr bool PERM = true, HAS_MID = false;
    bf16* O; int ldc; float sc;
    __device__ __forceinline__ void operator()(const f32x4 (&acc)[2][2][4][2], const Unit& u, int wr, int wc, int fr, int fq) const {
        const int row0 = u.po * 256 + wr * 64 + fr, col0 = u.pn * 256 + wc * 32 + 8 * fq;
#pragma unroll
        for (int ai = 0; ai < 2; ++ai)
#pragma unroll
            for (int m = 0; m < 4; ++m) { bf16* rowp = O + (size_t)(row0 + ai * 128 + m * 16) * ldc + col0;
#pragma unroll
                for (int bj = 0; bj < 2; ++bj) { const f32x4 v0 = acc[ai][bj][m][0] * sc, v1 = acc[ai][bj][m][1] * sc; u32x4 w;
                    w.x = cvt_pk_bf16(v0[0], v0[1]); w.y = cvt_pk_bf16(v0[2], v0[3]); w.z = cvt_pk_bf16(v1[0], v1[1]); w.w = cvt_pk_bf16(v1[2], v1[3]);
                    st16(rowp + bj * 128, w); } }
    }
};
struct Frame {
    LAS unsigned char* lds;
    int tid, lane, wave, G;
    unsigned char* ws;
};
__device__ __forceinline__ float wave_sum(float v) {
#pragma unroll
    for (int o = 1; o < 64; o <<= 1) v += __shfl_xor(v, o);
    return v;
}
#define LDS_WAIT() asm volatile("s_waitcnt lgkmcnt(0)" ::: "memory")
__device__ __forceinline__ Frame phase_frame(const Frame& F0) {
    Frame F = F0; int w = F0.wave; asm volatile("" : "+s"(w)); F.wave = w;
    int ln; asm volatile("v_mbcnt_lo_u32_b32 %0, -1, 0\n\tv_mbcnt_hi_u32_b32 %0, -1, %0" : "=&v"(ln));
    F.lane = ln; F.tid = w * 64 + ln;
    int g = F0.G; asm volatile("" : "+s"(g)); F.G = g; unsigned char* p = F0.ws; asm volatile("" : "+s"(p)); F.ws = p; return F; }

__device__ __forceinline__ float wave_max(float v) {
#pragma unroll
    for (int o = 1; o < 64; o <<= 1) v = fmaxf(v, __shfl_xor(v, o));
    return v;
}
__device__ __forceinline__ unsigned pack4_i8(float a, float b, float c, float d) { return ((unsigned)(int)rintf(a) & 255u) | (((unsigned)(int)rintf(b) & 255u) << 8) | (((unsigned)(int)rintf(c) & 255u) << 16) | ((unsigned)(int)rintf(d) << 24); }
template <int OUT8 = 0> __device__ __forceinline__ void transpose_item(const float* W, int ld, int col0, int k0, bf16* WT, int pitch, int row0, LAS float* scr, int lane, const unsigned* cmax = nullptr) {
    f32x4 wv[8];
#pragma unroll
    for (int i = 0; i < 8; ++i) wv[i] = *(const f32x4*)(W + (size_t)(k0 + 8 * i + (lane >> 3)) * ld + col0 + 4 * (lane & 7));
#pragma unroll
    for (int i = 0; i < 8; ++i) { LAS float* d = scr + (8 * i + (lane >> 3)) * 33 + 4 * (lane & 7); d[0] = wv[i][0]; d[1] = wv[i][1]; d[2] = wv[i][2]; d[3] = wv[i][3]; }
    LDS_WAIT(); asm volatile("" ::: "memory");
    const int c = lane & 7;
#pragma unroll
    for (int j = 0; j < 4; ++j) { const int n = (lane >> 3) + 8 * j; const LAS float* s = scr + (8 * c) * 33 + n;
        if constexpr (OUT8 == 2) { const float cm = __uint_as_float(cmax[row0 + n]), sc = cm > 0.f ? 127.0f / cm : 0.f;
            u32x2 o; o.x = pack4_i8(s[0 * 33] * sc, s[1 * 33] * sc, s[2 * 33] * sc, s[3 * 33] * sc); o.y = pack4_i8(s[4 * 33] * sc, s[5 * 33] * sc, s[6 * 33] * sc, s[7 * 33] * sc);
            st8((unsigned char*)WT + (size_t)(row0 + n) * pitch + k0 + 8 * c, o); continue; }
        if constexpr (OUT8 == 1) {
            u32x2 o; o.x = cvt_pk4_fp8(s[0 * 33] * F8_WSCALE, s[1 * 33] * F8_WSCALE, s[2 * 33] * F8_WSCALE, s[3 * 33] * F8_WSCALE); o.y = cvt_pk4_fp8(s[4 * 33] * F8_WSCALE, s[5 * 33] * F8_WSCALE, s[6 * 33] * F8_WSCALE, s[7 * 33] * F8_WSCALE);
            st8((unsigned char*)WT + (size_t)(row0 + n) * pitch + k0 + 8 * c, o); continue; }
        u32x4 o; o.x = cvt_pk_bf16(s[0 * 33], s[1 * 33]); o.y = cvt_pk_bf16(s[2 * 33], s[3 * 33]); o.z = cvt_pk_bf16(s[4 * 33], s[5 * 33]); o.w = cvt_pk_bf16(s[6 * 33], s[7 * 33]);
        st16(WT + (size_t)(row0 + n) * pitch + k0 + 8 * c, o); }
    LDS_WAIT(); asm volatile("" ::: "memory");
}
template <int MAP, int OUT8 = 0> __device__ __forceinline__ void transpose_matrix(const Frame& F, int& rot, const float* W, const float* W2, int ld, int K, int Nv, bf16* WT, LAS float* scr, int pitch = 0, const unsigned* cmax = nullptr) {
    if (pitch == 0) pitch = K;
    const int NGW = F.G * NWAVES; int gw = blockIdx.x * NWAVES + F.wave - rot; if (gw < 0) gw += NGW;
    const int ngrp = Nv / 32, nitems = (K / 64) * ngrp;
    rot = (rot + nitems) % NGW;
    for (int it = gw; it < nitems; it += NGW) {
        const int kb = it / ngrp, g = it % ngrp; const float* src = W; int col0 = 32 * g;
        if (MAP == 1) { if (g < 72) { const int tile = g >> 3, q = g & 7; col0 = 256 * tile + 64 * (q & 3) + 32 * (q >> 2); } }
        if (MAP == 2) { const int tile = g >> 3, q = g & 7; if (q < 4) { col0 = 128 * tile + 32 * q; } else { src = W2; col0 = 128 * tile + 32 * (q - 4); } }
        transpose_item<OUT8>(src, ld, col0, 64 * kb, WT, pitch, 32 * g, scr, F.lane, cmax);
    }
}
template <int MAP> __device__ __forceinline__ void transpose_matrix_f8(const Frame& F, int& rot, const float* W, const float* W2, int ld, int K, int Nv, unsigned char* WT, LAS float* scr, int pitch) {
    const int NGW = F.G * NWAVES; int gw = blockIdx.x * NWAVES + F.wave - rot; if (gw < 0) gw += NGW;
    const int ngrp = Nv / 32, nitems = (K / 128) * ngrp;
    rot = (rot + nitems) % NGW;
    const int lane = F.lane;
    for (int it = gw; it < nitems; it += NGW) {
        const int kb = it / ngrp, g = it % ngrp; const float* src = W; int col0 = 32 * g;
        if (MAP == 2) { const int tile = g >> 3, q = g & 7; if (q < 4) { col0 = 128 * tile + 32 * q; } else { src = W2; col0 = 128 * tile + 32 * (q - 4); } }
        const int k0 = 128 * kb;
        f32x4 wv[16];
#pragma unroll
        for (int i = 0; i < 16; ++i) wv[i] = *(const f32x4*)(src + (size_t)(k0 + 8 * i + (lane >> 3)) * ld + col0 + 4 * (lane & 7));
#pragma unroll
        for (int i = 0; i < 16; ++i) { const int kk = 8 * i + (lane >> 3); LAS float* d = scr + kk * 33 + ((4 * (lane & 7) + 8 * (kk >> 4)) & 31); d[0] = wv[i][0]; d[1] = wv[i][1]; d[2] = wv[i][2]; d[3] = wv[i][3]; }
        LDS_WAIT(); asm volatile("" ::: "memory");
        const int c = lane & 7;
#pragma unroll
        for (int j = 0; j < 4; ++j) { const int n = (lane >> 3) + 8 * j; const LAS float* s = scr + (16 * c) * 33 + ((n + 8 * c) & 31);
            u32x4 o; o.x = cvt_pk4_fp8(s[0 * 33] * F8_WSCALE, s[1 * 33] * F8_WSCALE, s[2 * 33] * F8_WSCALE, s[3 * 33] * F8_WSCALE); o.y = cvt_pk4_fp8(s[4 * 33] * F8_WSCALE, s[5 * 33] * F8_WSCALE, s[6 * 33] * F8_WSCALE, s[7 * 33] * F8_WSCALE);
            o.z = cvt_pk4_fp8(s[8 * 33] * F8_WSCALE, s[9 * 33] * F8_WSCALE, s[10 * 33] * F8_WSCALE, s[11 * 33] * F8_WSCALE); o.w = cvt_pk4_fp8(s[12 * 33] * F8_WSCALE, s[13 * 33] * F8_WSCALE, s[14 * 33] * F8_WSCALE, s[15 * 33] * F8_WSCALE);
            st16(WT + (size_t)(32 * g + n) * pitch + k0 + 16 * c, o); }
        LDS_WAIT(); asm volatile("" ::: "memory");
    }
}
template <int MAP> __device__ __forceinline__ void colmax_matrix(const Frame& F, int& rot, const float* W, const float* W2, int ld, int K, int Nv, unsigned* cmax) {
    const int NGW = F.G * NWAVES; int gw = blockIdx.x * NWAVES + F.wave - rot; if (gw < 0) gw += NGW;
    const int ngrp = Nv / 32, nitems = (K / 64) * ngrp;
    rot = (rot + nitems) % NGW;
    const int lane = F.lane;
    for (int it = gw; it < nitems; it += NGW) {
        const int kb = it / ngrp, g = it % ngrp; const float* src = W; int col0 = 32 * g;
        if (MAP == 1) { if (g < 72) { const int tile = g >> 3, q = g & 7; col0 = 256 * tile + 64 * (q & 3) + 32 * (q >> 2); } }
        if (MAP == 2) { const int tile = g >> 3, q = g & 7; if (q < 4) { col0 = 128 * tile + 32 * q; } else { src = W2; col0 = 128 * tile + 32 * (q - 4); } }
        f32x4 mx = {0.f, 0.f, 0.f, 0.f};
#pragma unroll
        for (int i = 0; i < 8; ++i) { const f32x4 w = *(const f32x4*)(src + (size_t)(64 * kb + 8 * i + (lane >> 3)) * ld + col0 + 4 * (lane & 7));
#pragma unroll
            for (int e = 0; e < 4; ++e) mx[e] = fmaxf(mx[e], fabsf(w[e])); }
#pragma unroll
        for (int e = 0; e < 4; ++e) { mx[e] = fmaxf(mx[e], __shfl_xor(mx[e], 8)); mx[e] = fmaxf(mx[e], __shfl_xor(mx[e], 16)); mx[e] = fmaxf(mx[e], __shfl_xor(mx[e], 32)); }
        if (lane < 8) {
#pragma unroll
            for (int e = 0; e < 4; ++e) atomicMax(cmax + 32 * g + 4 * lane + e, __float_as_uint(mx[e])); }
    }
}
template <bool ROUTER, bool SRCBF = true, bool WRITE = true, int OUT8 = 0  , bool ALSO8 = false> __device__ __forceinline__ void norm_rows(const Frame& F, const void* src, const float* gain, bf16* dst, int rows, const float* wrouter, int* tok_e, float* tok_w, float* rtok = nullptr, unsigned char* dst8 = nullptr, float* rscale = nullptr) {
    const int gw = blockIdx.x * NWAVES + F.wave, NGW = F.G * NWAVES;
    f32x4 gv[4];
#pragma unroll
    for (int j = 0; j < 4; ++j) gv[j] = *(const f32x4*)(gain + 4 * F.lane + 256 * j);
    constexpr int NRB = 4;
    for (int m0 = gw; m0 < rows; m0 += NRB * NGW) {
      u32x2 rawb[NRB][4]; f32x4 rawf[NRB][4];
#pragma unroll
      for (int i = 0; i < NRB; ++i) { const int mi = m0 + i * NGW, m = mi < rows ? mi : rows - 1;
#pragma unroll
          for (int j = 0; j < 4; ++j) { if (SRCBF) rawb[i][j] = ((const u32x2*)((const bf16*)src + (size_t)m * D) + F.lane)[64 * j]; else rawf[i][j] = ((const f32x4*)((const float*)src + (size_t)m * D) + F.lane)[64 * j]; } }
#pragma unroll
      for (int i = 0; i < NRB; ++i) { const int m = m0 + i * NGW; if (m >= rows) break;
        f32x4 v[4]; float s = 0.f;
#pragma unroll
        for (int j = 0; j < 4; ++j) {
            if (SRCBF) { const u32x2 w = rawb[i][j]; v[j] = (f32x4){bflo(w.x), bfhi(w.x), bflo(w.y), bfhi(w.y)}; }
            else v[j] = rawf[i][j];
            s += (v[j][0] * v[j][0] + v[j][1] * v[j][1]) + (v[j][2] * v[j][2] + v[j][3] * v[j][3]); }
        const float r = 1.0f / sqrtf(wave_sum(s) * (1.0f / D) + EPS);
        u32x2* o8 = (u32x2*)(dst + (size_t)m * D) + F.lane;
        if constexpr (OUT8 == 2) { float am = 0.f;
#pragma unroll
            for (int j = 0; j < 4; ++j) { v[j] = v[j] * r * gv[j]; am = fmaxf(fmaxf(am, fmaxf(fabsf(v[j][0]), fabsf(v[j][1]))), fmaxf(fabsf(v[j][2]), fabsf(v[j][3]))); }
            am = wave_max(am); const float inv = am > 0.f ? 127.0f / am : 0.f;
#pragma unroll
            for (int j = 0; j < 4; ++j) ((unsigned*)((unsigned char*)dst + (size_t)m * D) + F.lane)[64 * j] = pack4_i8(v[j][0] * inv, v[j][1] * inv, v[j][2] * inv, v[j][3] * inv);
            if (F.lane == 0) rscale[m] = am * (1.0f / 127.0f);
            continue; }
#pragma unroll
        for (int j = 0; j < 4; ++j) { v[j] = v[j] * r * gv[j]; if (ALSO8) ((unsigned*)(dst8 + (size_t)m * D) + F.lane)[64 * j] = cvt_pk4_fp8(v[j][0], v[j][1], v[j][2], v[j][3]);
            if (WRITE && OUT8 == 1) { ((unsigned*)((unsigned char*)dst + (size_t)m * D) + F.lane)[64 * j] = cvt_pk4_fp8(v[j][0], v[j][1], v[j][2], v[j][3]); } else if (WRITE) { u32x2 w; w.x = cvt_pk_bf16(v[j][0], v[j][1]); w.y = cvt_pk_bf16(v[j][2], v[j][3]); st8(o8 + 64 * j, w); } }
        if (ROUTER) {
            float lg[8];
#pragma unroll
            for (int e = 0; e < 8; ++e) lg[e] = 0.f;
#pragma unroll
            for (int j = 0; j < 4; ++j)
#pragma unroll
                for (int c = 0; c < 4; ++c) { const float* wp = wrouter + (size_t)(4 * F.lane + 256 * j + c) * 8; const f32x4 w0 = *(const f32x4*)wp, w1 = *(const f32x4*)(wp + 4); const float hv = v[j][c];
                    lg[0] = fmaf(hv, w0[0], lg[0]); lg[1] = fmaf(hv, w0[1], lg[1]); lg[2] = fmaf(hv, w0[2], lg[2]); lg[3] = fmaf(hv, w0[3], lg[3]);
                    lg[4] = fmaf(hv, w1[0], lg[4]); lg[5] = fmaf(hv, w1[1], lg[5]); lg[6] = fmaf(hv, w1[2], lg[6]); lg[7] = fmaf(hv, w1[3], lg[7]); }
#pragma unroll
            for (int e = 0; e < 8; ++e) lg[e] = wave_sum(lg[e]);
            if (F.lane == 0) {
                int i1 = 0; float v1 = lg[0];
#pragma unroll
                for (int e = 1; e < 8; ++e) if (lg[e] > v1) { v1 = lg[e]; i1 = e; }
                int i2 = 0; float v2 = -INFINITY;
#pragma unroll
                for (int e = 0; e < 8; ++e) if (e != i1 && lg[e] > v2) { v2 = lg[e]; i2 = e; }
                const float e2 = expf(v2 - v1); const float w1 = 1.0f / (1.0f + e2);
                tok_e[2 * m] = i1; tok_e[2 * m + 1] = i2; tok_w[2 * m] = w1; tok_w[2 * m + 1] = e2 * w1; if (rtok) rtok[m] = r;
            }
        }
      }
    }
}
__device__ __forceinline__ void moe_route(const Frame& F, const int* tok_e, int* tok_slot, int* rowmap, int* meta) {
    LAS int* cnt = (LAS int*)F.lds;
    LAS int* tot = cnt + 8 * 512;
    const int t0 = F.tid * 32;
    int c[8];
#pragma unroll
    for (int e = 0; e < 8; ++e) c[e] = 0;
    for (int i = 0; i < 64; ++i) { const int e = tok_e[2 * t0 + i];
#pragma unroll
        for (int k = 0; k < 8; ++k) c[k] += (e == k) ? 1 : 0; }
#pragma unroll
    for (int e = 0; e < 8; ++e) cnt[e * 512 + F.tid] = c[e];
    __syncthreads();
    {
        const int e = F.wave; int v[8]; int s = 0;
#pragma unroll
        for (int k = 0; k < 8; ++k) { v[k] = cnt[e * 512 + F.lane * 8 + k]; s += v[k]; }
        int incl = s;
#pragma unroll
        for (int o = 1; o < 64; o <<= 1) { const int y = __shfl_up(incl, o); if (F.lane >= o) incl += y; }
        int run = incl - s;
#pragma unroll
        for (int k = 0; k < 8; ++k) { cnt[e * 512 + F.lane * 8 + k] = run; run += v[k]; }
        if (F.lane == 63) tot[e] = incl;
    }
    __syncthreads();
    if (F.tid == 0) { int base = 0, rt = 0;
        for (int e = 0; e < 8; ++e) { const int n = tot[e], nt = (n + 255) >> 8; tot[8 + e] = base;
            for (int k = 0; k < nt; ++k) meta[16 + rt + k] = e;
            rt += nt; base += nt * 256; }
        meta[0] = rt; }
    __syncthreads();
    for (int e = 0; e < 8; ++e) { const int n = tot[e], base = tot[8 + e], end = base + (((n + 255) >> 8) << 8);
        for (int s = base + n + F.tid; s < end; s += 512) rowmap[s] = 0; }
    int run[8];
#pragma unroll
    for (int e = 0; e < 8; ++e) run[e] = tot[8 + e] + cnt[e * 512 + F.tid];
    for (int i = 0; i < 64; ++i) { const int e = tok_e[2 * t0 + i]; int slot = 0;
#pragma unroll
        for (int k = 0; k < 8; ++k) if (e == k) { slot = run[k]; run[k] += 1; }
        tok_slot[2 * t0 + i] = slot; rowmap[slot] = t0 + (i >> 1); }
    __syncthreads();
}
__device__ __forceinline__ void combine_final(const Frame& F, const bf16* x, const bf16* Y, const int* tok_slot, const float* tok_w, const float* gain, float* out) {
    const int gw = blockIdx.x * NWAVES + F.wave, NGW = F.G * NWAVES;
    f32x4 gv[4];
#pragma unroll
    for (int j = 0; j < 4; ++j) gv[j] = *(const f32x4*)(gain + 4 * F.lane + 256 * j);
    constexpr int NRB = 4;
    for (int m0 = gw; m0 < M; m0 += NRB * NGW) {
      int s1v[NRB], s2v[NRB]; float w1v[NRB], w2v[NRB];
#pragma unroll
      for (int i = 0; i < NRB; ++i) { const int mi = m0 + i * NGW, m = mi < M ? mi : M - 1; const u32x2 sl = *(const u32x2*)(tok_slot + 2 * m); const f32x2 tw = *(const f32x2*)(tok_w + 2 * m); s1v[i] = (int)sl.x; s2v[i] = (int)sl.y; w1v[i] = tw[0]; w2v[i] = tw[1]; }
      u32x2 rx[NRB][4], ra[NRB][4], rb[NRB][4];
#pragma unroll
      for (int i = 0; i < NRB; ++i) { const int mi = m0 + i * NGW, m = mi < M ? mi : M - 1;
        const u32x2* xr = (const u32x2*)(x + (size_t)m * D) + F.lane; const u32x2* y1 = (const u32x2*)(Y + (size_t)s1v[i] * D) + F.lane; const u32x2* y2 = (const u32x2*)(Y + (size_t)s2v[i] * D) + F.lane;
#pragma unroll
        for (int j = 0; j < 4; ++j) { rx[i][j] = xr[64 * j]; ra[i][j] = y1[64 * j]; rb[i][j] = y2[64 * j]; } }
#pragma unroll
      for (int i = 0; i < NRB; ++i) { const int m = m0 + i * NGW; if (m >= M) break; const float w1 = w1v[i], w2 = w2v[i];
        f32x4 v[4]; float s = 0.f;
#pragma unroll
        for (int j = 0; j < 4; ++j) { const u32x2 xw = rx[i][j]; v[j] = (f32x4){bflo(xw.x), bfhi(xw.x), bflo(xw.y), bfhi(xw.y)}; const u32x2 a = ra[i][j], b = rb[i][j];
            v[j][0] += w1 * bflo(a.x) + w2 * bflo(b.x); v[j][1] += w1 * bfhi(a.x) + w2 * bfhi(b.x); v[j][2] += w1 * bflo(a.y) + w2 * bflo(b.y); v[j][3] += w1 * bfhi(a.y) + w2 * bfhi(b.y);
            s += (v[j][0] * v[j][0] + v[j][1] * v[j][1]) + (v[j][2] * v[j][2] + v[j][3] * v[j][3]); }
        const float r = 1.0f / sqrtf(wave_sum(s) * (1.0f / D) + EPS);
        f32x4* o = (f32x4*)(out + (size_t)m * D) + F.lane;
#pragma unroll
        for (int j = 0; j < 4; ++j) o[64 * j] = v[j] * r * gv[j];
      }
    }
}

__device__ __forceinline__ int pi32(int r) { return (r & ~12) | ((r & 4) << 1) | ((r & 8) >> 1); }
#define MFMA32(a, b, c) __builtin_amdgcn_mfma_f32_32x32x16_bf16((a), (b), (c), 0, 0, 0)
template <int ND0> __device__ __forceinline__ f32x16 qk_tile(const bf16* Kh, int key0, const bf16x8* qr, int r32, int hi) {
    const bf16* kp = Kh + (size_t)(key0 >> 5) * (ND0 * 512) + (size_t)(hi * 32 + r32) * 8;
    f32x16 s = {0.f, 0.f, 0.f, 0.f, 0.f, 0.f, 0.f, 0.f, 0.f, 0.f, 0.f, 0.f, 0.f, 0.f, 0.f, 0.f};
#pragma unroll
    for (int d0 = 0; d0 < ND0; ++d0) { const bf16x8 kf = *(const GAS bf16x8*)(kp + d0 * 512); s = MFMA32(kf, qr[d0], s); }
    return s;
}
template <int NDT> __device__ __forceinline__ void pv_tile(const bf16* Vt, int, int key0, bf16x8 p0, bf16x8 p1, f32x16* o, int r32, int hi) {
    const bf16* vp = Vt + (size_t)(key0 >> 5) * (NDT * 1024) + (size_t)(hi * 32 + r32) * 8;
#pragma unroll
    for (int dt = 0; dt < NDT; ++dt) { const bf16x8 v0 = *(const GAS bf16x8*)(vp + dt * 1024), v1 = *(const GAS bf16x8*)(vp + dt * 1024 + 512);
        o[dt] = MFMA32(v0, p0, o[dt]); o[dt] = MFMA32(v1, p1, o[dt]); }
}
__device__ __forceinline__ bf16x8 pack8(const f32x16& p, int b) {
    u32x4 w; w.x = cvt_pk_bf16(p[b], p[b + 1]); w.y = cvt_pk_bf16(p[b + 2], p[b + 3]); w.z = cvt_pk_bf16(p[b + 4], p[b + 5]); w.w = cvt_pk_bf16(p[b + 6], p[b + 7]);
    return __builtin_bit_cast(bf16x8, w);
}
__device__ __forceinline__ float xhalf_max(float v) { auto rr = __builtin_amdgcn_permlane32_swap(__float_as_uint(v), __float_as_uint(v), false, false); return fmaxf(__uint_as_float(rr[0]), __uint_as_float(rr[1])); }
__device__ __forceinline__ float xhalf_sum(float v) { auto rr = __builtin_amdgcn_permlane32_swap(__float_as_uint(v), __float_as_uint(v), false, false); return __uint_as_float(rr[0]) + __uint_as_float(rr[1]); }
template <int NDT> __device__ __forceinline__ void softmax_step(f32x16& s, float& m, float& l, f32x16* o, bf16x8& p0, bf16x8& p1) {
    float tm = fmaxf(fmaxf(s[0], s[1]), fmaxf(s[2], s[3]));
#pragma unroll
    for (int r = 4; r < 16; r += 4) tm = fmaxf(tm, fmaxf(fmaxf(s[r], s[r + 1]), fmaxf(s[r + 2], s[r + 3])));
    tm = xhalf_max(tm);
    const float mn = fmaxf(m, tm), al = fast_exp2(m - mn); m = mn;
    float ps = 0.f;
#pragma unroll
    for (int r = 0; r < 16; ++r) { s[r] = fast_exp2(s[r] - mn); ps += s[r]; }
    l = l * al + ps;
#pragma unroll
    for (int dt = 0; dt < NDT; ++dt)
#pragma unroll
        for (int r = 0; r < 16; ++r) o[dt][r] *= al;
    p0 = pack8(s, 0); p1 = pack8(s, 8);
}
template <int NDT> __device__ __forceinline__ void store_o(bf16* Orow  , const f32x16* o, float scale, int hi) {
#pragma unroll
    for (int dt = 0; dt < NDT; ++dt)
#pragma unroll
        for (int g = 0; g < 4; ++g) { u32x2 w; w.x = cvt_pk_bf16(o[dt][4 * g] * scale, o[dt][4 * g + 1] * scale); w.y = cvt_pk_bf16(o[dt][4 * g + 2] * scale, o[dt][4 * g + 3] * scale);
            st8(Orow + dt * 32 + 8 * g + 4 * hi, w); }
}
template <int ND0> __device__ __forceinline__ void load_q(bf16x8* qr, const bf16* Qh  , int t0, int r32, int hi) {
#pragma unroll
    for (int d0 = 0; d0 < ND0; ++d0) qr[d0] = *(const GAS bf16x8*)(Qh + (size_t)(t0 + r32) * (16 * ND0) + d0 * 16 + hi * 8);
}
#define KEY_OF(r, hi) (16 * ((r) >> 3) + 8 * (hi) + ((r) & 7))

template <int ND0> __device__ __forceinline__ void load_k(bf16x8* kf, const bf16* Kh, int key0, int r32, int hi) {
    const bf16* kp = Kh + (size_t)(key0 >> 5) * (ND0 * 512) + (size_t)(hi * 32 + r32) * 8;
#pragma unroll
    for (int d0 = 0; d0 < ND0; ++d0) kf[d0] = *(const GAS bf16x8*)(kp + d0 * 512);
}
template <int NDT> __device__ __forceinline__ void load_v(bf16x8* vf, const bf16* Vt, int  , int key0, int r32, int hi) {
    const bf16* vp = Vt + (size_t)(key0 >> 5) * (NDT * 1024) + (size_t)(hi * 32 + r32) * 8;
#pragma unroll
    for (int dt = 0; dt < NDT; ++dt) { vf[2 * dt] = *(const GAS bf16x8*)(vp + dt * 1024); vf[2 * dt + 1] = *(const GAS bf16x8*)(vp + dt * 1024 + 512); }
}
template <int MK> __device__ __forceinline__ void apply_mask(f32x16& s, int r32, int hi) {
    if (MK == 1) {
#pragma unroll
        for (int r = 0; r < 16; ++r) if (KEY_OF(r, hi) > r32) s[r] = -INFINITY; }
    if (MK == 2) {
#pragma unroll
        for (int r = 0; r < 16; ++r) if (KEY_OF(r, hi) <= r32) s[r] = -INFINITY; }
}
__device__ __forceinline__ float max16(const f32x16& s) {
    float a = fmaxf(fmaxf(s[0], s[1]), fmaxf(s[2], s[3]));
#pragma unroll
    for (int r = 4; r < 16; r += 4) a = fmaxf(a, fmaxf(fmaxf(s[r], s[r + 1]), fmaxf(s[r + 2], s[r + 3])));
    return a;
}
template <int ND0, int NDT, bool HAS2, int MA, int MB>
__device__ __forceinline__ void flash_compute(const bf16x8* kfa, const bf16x8* kfb, const bf16x8* va, const bf16x8* vb, const bf16x8* qr, float lane_inf, float& m, float& l, f32x16* o, int r32, int hi);
template <int ND0, int NDT, bool HAS2, int MA, int MB>
__device__ __forceinline__ void flash_step(const bf16x8* kfa, const bf16x8* kfb, const bf16* Vt, int ldv, int key0a, int key0b, const bf16x8* qr, float lane_inf,
                                           float& m, float& l, f32x16* o, int r32, int hi) {
    bf16x8 va[2 * NDT], vb[2 * NDT];
    load_v<NDT>(va, Vt, ldv, key0a, r32, hi);
    if (HAS2) load_v<NDT>(vb, Vt, ldv, key0b, r32, hi);
    flash_compute<ND0, NDT, HAS2, MA, MB>(kfa, kfb, va, vb, qr, lane_inf, m, l, o, r32, hi);
}
template <int ND0, int NDT, bool HAS2, int MA, int MB>
__device__ __forceinline__ void flash_compute(const bf16x8* kfa, const bf16x8* kfb, const bf16x8* va, const bf16x8* vb, const bf16x8* qr, float lane_inf, float& m, float& l, f32x16* o, int r32, int hi) {
    f32x16 sa = {0.f, 0.f, 0.f, 0.f, 0.f, 0.f, 0.f, 0.f, 0.f, 0.f, 0.f, 0.f, 0.f, 0.f, 0.f, 0.f}, sb = sa;
#pragma unroll
    for (int d0 = 0; d0 < ND0; ++d0) { sa = MFMA32(kfa[d0], qr[d0], sa); if (HAS2) sb = MFMA32(kfb[d0], qr[d0], sb); }
    apply_mask<MA>(sa, r32, hi); if (HAS2) apply_mask<MB>(sb, r32, hi);
    float tm = max16(sa); if (HAS2) tm = fmaxf(tm, max16(sb));
    tm = xhalf_max(tm) - lane_inf;
    if (__builtin_amdgcn_ballot_w64(tm > m) != 0ull) {
        const float mn = fmaxf(m, tm), al = fast_exp2(m - mn); m = mn; l *= al;
#pragma unroll
        for (int dt = 0; dt < NDT; ++dt)
#pragma unroll
            for (int r = 0; r < 16; ++r) o[dt][r] *= al;
    }
    const float ms = m + lane_inf;
    float ps = 0.f;
#pragma unroll
    for (int r = 0; r < 16; ++r) { sa[r] = fast_exp2(sa[r] - ms); ps += sa[r]; }
    if (HAS2) {
#pragma unroll
        for (int r = 0; r < 16; ++r) { sb[r] = fast_exp2(sb[r] - ms); ps += sb[r]; } }
    l += ps;
    const bf16x8 pa0 = pack8(sa, 0), pa1 = pack8(sa, 8);
#pragma unroll
    for (int dt = 0; dt < NDT; ++dt) { o[dt] = MFMA32(va[2 * dt], pa0, o[dt]); o[dt] = MFMA32(va[2 * dt + 1], pa1, o[dt]); }
    if (HAS2) { const bf16x8 pb0 = pack8(sb, 0), pb1 = pack8(sb, 8);
#pragma unroll
        for (int dt = 0; dt < NDT; ++dt) { o[dt] = MFMA32(vb[2 * dt], pb0, o[dt]); o[dt] = MFMA32(vb[2 * dt + 1], pb1, o[dt]); } }
}
#define COPY_K(dst, src, N) do { _Pragma("unroll") for (int _d = 0; _d < (N); ++_d) dst[_d] = src[_d]; } while (0)

__device__ __forceinline__ void moba_item(const Frame& F, int b, int h, int qt, const float* kmean) {
    const int lane = F.lane, r32 = lane & 31, hi = lane >> 5, r32p = pi32(r32);
    const bf16* Qh = (const bf16*)(F.ws + WS_HEADS + HD_QA) + (size_t)(b * 4 + h) * T * 64;
    const bf16* Kh = (const bf16*)(F.ws + WS_HEADS + HD_KA) + (size_t)(b * 4 + h) * T * 64;
    const bf16* Vt = (const bf16*)(F.ws + WS_HEADS + HD_VTA) + (size_t)(b * 4 + h) * 64 * T;
    const int t0 = qt * 32, own = t0 >> 8;
    bf16x8 qr[4]; load_q<4>(qr, Qh, t0, r32, hi);
    bf16x8 kfa[4], kfb[4], kna[4], knb[4];
    const int NT = qt + 1;
    load_k<4>(kfa, Kh, 0, r32, hi); if (NT > 1) load_k<4>(kfb, Kh, 32, r32, hi);
    unsigned selmask = 0u;
    if (own > 0) {
        float sc[16];
        const float* km = kmean + (size_t)(b * 4 + h) * 16 * 64 + hi * 8;
        float qf[32];
#pragma unroll
        for (int d0 = 0; d0 < 4; ++d0) { const u32x4 w = __builtin_bit_cast(u32x4, qr[d0]); qf[8 * d0 + 0] = bflo(w.x); qf[8 * d0 + 1] = bfhi(w.x); qf[8 * d0 + 2] = bflo(w.y); qf[8 * d0 + 3] = bfhi(w.y);
            qf[8 * d0 + 4] = bflo(w.z); qf[8 * d0 + 5] = bfhi(w.z); qf[8 * d0 + 6] = bflo(w.w); qf[8 * d0 + 7] = bfhi(w.w); }
#pragma unroll
        for (int j = 0; j < 15; ++j) { float a = 0.f;
            if (j < own) {
#pragma unroll
                for (int d0 = 0; d0 < 4; ++d0) { const f32x4 k0 = *(const f32x4*)(km + j * 64 + d0 * 16), k1 = *(const f32x4*)(km + j * 64 + d0 * 16 + 4);
                    a = fmaf(qf[8 * d0 + 0], k0[0], a); a = fmaf(qf[8 * d0 + 1], k0[1], a); a = fmaf(qf[8 * d0 + 2], k0[2], a); a = fmaf(qf[8 * d0 + 3], k0[3], a);
                    a = fmaf(qf[8 * d0 + 4], k1[0], a); a = fmaf(qf[8 * d0 + 5], k1[1], a); a = fmaf(qf[8 * d0 + 6], k1[2], a); a = fmaf(qf[8 * d0 + 7], k1[3], a); }
                a = xhalf_sum(a);
            } else a = -INFINITY;
            sc[j] = a; }
        sc[15] = -INFINITY;
        const int nsel = own < 3 ? own : 3;
#pragma unroll
        for (int r = 0; r < 3; ++r) if (r < nsel) { int bi = 0; float bv = -INFINITY;
#pragma unroll
            for (int j = 0; j < 15; ++j) if (sc[j] > bv) { bv = sc[j]; bi = j; }
            selmask |= 1u << bi;
#pragma unroll
            for (int j = 0; j < 15; ++j) if (j == bi) sc[j] = -INFINITY; }
    }
    selmask |= 1u << own;
    float m = -1e30f, l = 0.f; f32x16 o[2];
#pragma unroll
    for (int dt = 0; dt < 2; ++dt)
#pragma unroll
        for (int r = 0; r < 16; ++r) o[dt][r] = 0.f;
    const int nfull = (NT - 1) >> 1;
    for (int s = 0; s < nfull; ++s) {
        const int key0 = 64 * s;
        if (2 * s + 2 < NT) load_k<4>(kna, Kh, key0 + 64, r32, hi);
        if (2 * s + 3 < NT) load_k<4>(knb, Kh, key0 + 96, r32, hi);
        const float lane_inf = ((selmask >> (s >> 2)) & 1u) ? 0.f : INFINITY;
        flash_step<4, 2, true, 0, 0>(kfa, kfb, Vt, T, key0, key0 + 32, qr, lane_inf, m, l, o, r32, hi);
        COPY_K(kfa, kna, 4); COPY_K(kfb, knb, 4);
    }
    if (NT & 1) flash_step<4, 2, false, 1, 0>(kfa, kfb, Vt, T, 64 * nfull, 0, qr, 0.f, m, l, o, r32, hi);
    else        flash_step<4, 2, true, 0, 1>(kfa, kfb, Vt, T, 64 * nfull, 64 * nfull + 32, qr, 0.f, m, l, o, r32, hi);
    l = xhalf_sum(l);
    bf16* Orow = (bf16*)(F.ws + WS_O) + (size_t)(b * T + t0 + r32) * D + O_A + h * 64;
    store_o<2>(Orow, o, fast_rcp(l), hi);
}
__device__ __forceinline__ void moba_wg(const Frame& F, int b, int h, int qt, int S_total, const float* kmean) {
    const int lane = F.lane, r32 = lane & 31, hi = lane >> 5;
    const bf16* Qh = (const bf16*)(F.ws + WS_HEADS + HD_QA) + (size_t)(b * 4 + h) * T * 64;
    const unsigned char* Kg = F.ws + WS_HEADS + HD_KA + (size_t)(b * 4 + h) * T * 64 * 2;
    const unsigned char* Vg = F.ws + WS_HEADS + HD_VTA + (size_t)(b * 4 + h) * 64 * T * 2;
    LAS unsigned char* ring = F.lds;
#define MW_ISSUE(s) do { const int _sc = (s) < S_total ? (s) : S_total - 1; \
        __builtin_amdgcn_global_load_lds((const unsigned*)(Kg + (size_t)_sc * 8192 + F.wave * 1024 + lane * 16), (LAS unsigned*)(ring + ((s) & 3) * 16384 + F.wave * 1024), 16, 0, 0); \
        __builtin_amdgcn_global_load_lds((const unsigned*)(Vg + (size_t)_sc * 8192 + F.wave * 1024 + lane * 16), (LAS unsigned*)(ring + ((s) & 3) * 16384 + 8192 + F.wave * 1024), 16, 0, 0); } while (0)
    const int t0 = qt * 32, own = t0 >> 8;
    bf16x8 qr[4]; load_q<4>(qr, Qh, t0, r32, hi);
    const int NT = qt + 1;
    unsigned selmask = 0u;
    if (own > 0) {
        float sc[16];
        const float* km = kmean + (size_t)(b * 4 + h) * 16 * 64 + hi * 8;
        float qf[32];
#pragma unroll
        for (int d0 = 0; d0 < 4; ++d0) { const u32x4 w = __builtin_bit_cast(u32x4, qr[d0]); qf[8 * d0 + 0] = bflo(w.x); qf[8 * d0 + 1] = bfhi(w.x); qf[8 * d0 + 2] = bflo(w.y); qf[8 * d0 + 3] = bfhi(w.y);
            qf[8 * d0 + 4] = bflo(w.z); qf[8 * d0 + 5] = bfhi(w.z); qf[8 * d0 + 6] = bflo(w.w); qf[8 * d0 + 7] = bfhi(w.w); }
#pragma unroll
        for (int j = 0; j < 15; ++j) { float a = 0.f;
            if (j < own) {
#pragma unroll
                for (int d0 = 0; d0 < 4; ++d0) { const f32x4 k0 = *(const f32x4*)(km + j * 64 + d0 * 16), k1 = *(const f32x4*)(km + j * 64 + d0 * 16 + 4);
                    a = fmaf(qf[8 * d0 + 0], k0[0], a); a = fmaf(qf[8 * d0 + 1], k0[1], a); a = fmaf(qf[8 * d0 + 2], k0[2], a); a = fmaf(qf[8 * d0 + 3], k0[3], a);
                    a = fmaf(qf[8 * d0 + 4], k1[0], a); a = fmaf(qf[8 * d0 + 5], k1[1], a); a = fmaf(qf[8 * d0 + 6], k1[2], a); a = fmaf(qf[8 * d0 + 7], k1[3], a); }
                a = xhalf_sum(a);
            } else a = -INFINITY;
            sc[j] = a; }
        sc[15] = -INFINITY;
        const int nsel = own < 3 ? own : 3;
#pragma unroll
        for (int r = 0; r < 3; ++r) if (r < nsel) { int bi = 0; float bv = -INFINITY;
#pragma unroll
            for (int j = 0; j < 15; ++j) if (sc[j] > bv) { bv = sc[j]; bi = j; }
            selmask |= 1u << bi;
#pragma unroll
            for (int j = 0; j < 15; ++j) if (j == bi) sc[j] = -INFINITY; }
    }
    selmask |= 1u << own;
    asm volatile("s_waitcnt vmcnt(0)" ::: "memory");
    MW_ISSUE(0); MW_ISSUE(1); MW_ISSUE(2);
    float m = -1e30f, l = 0.f; f32x16 o[2];
#pragma unroll
    for (int dt = 0; dt < 2; ++dt)
#pragma unroll
        for (int r = 0; r < 16; ++r) o[dt][r] = 0.f;
    const int nfull = (NT - 1) >> 1;
    for (int s = 0; s < S_total; ++s) {
        asm volatile("s_waitcnt vmcnt(4)" ::: "memory");
        __builtin_amdgcn_s_barrier();
        MW_ISSUE(s + 3);
        if (s <= nfull) {
            const LAS bf16* Kl = (const LAS bf16*)(ring + (s & 3) * 16384) + lane * 8; const LAS bf16* Vl = Kl + 4096;
            bf16x8 ka[4], kb[4], va[4], vb[4];
#pragma unroll
            for (int d0 = 0; d0 < 4; ++d0) { ka[d0] = *(const LAS bf16x8*)(Kl + d0 * 512); kb[d0] = *(const LAS bf16x8*)(Kl + 2048 + d0 * 512); }
#pragma unroll
            for (int dt = 0; dt < 2; ++dt) { va[2 * dt] = *(const LAS bf16x8*)(Vl + dt * 1024); va[2 * dt + 1] = *(const LAS bf16x8*)(Vl + dt * 1024 + 512);
                vb[2 * dt] = *(const LAS bf16x8*)(Vl + 2048 + dt * 1024); vb[2 * dt + 1] = *(const LAS bf16x8*)(Vl + 2048 + dt * 1024 + 512); }
            if (s < nfull) { const float lane_inf = ((selmask >> (s >> 2)) & 1u) ? 0.f : INFINITY; flash_compute<4, 2, true, 0, 0>(ka, kb, va, vb, qr, lane_inf, m, l, o, r32, hi); }
            else if (NT & 1) flash_compute<4, 2, false, 1, 0>(ka, kb, va, vb, qr, 0.f, m, l, o, r32, hi);
            else flash_compute<4, 2, true, 0, 1>(ka, kb, va, vb, qr, 0.f, m, l, o, r32, hi);
        }
    }
#undef MW_ISSUE
    l = xhalf_sum(l);
    bf16* Orow = (bf16*)(F.ws + WS_O) + (size_t)(b * T + t0 + r32) * D + O_A + h * 64;
    store_o<2>(Orow, o, fast_rcp(l), hi);
    asm volatile("s_waitcnt vmcnt(0)" ::: "memory");
    __syncthreads();
}
__device__ __forceinline__ void swa_item(const Frame& F, int b, int hq, int qt, const float* sinks) {
    const int lane = F.lane, r32 = lane & 31, hi = lane >> 5, r32p = pi32(r32); const int kvh = hq >> 2;
    const bf16* Qh = (const bf16*)(F.ws + WS_HEADS + HD_QB) + (size_t)(b * 8 + hq) * T * 64;
    const bf16* Kh = (const bf16*)(F.ws + WS_HEADS + HD_KB) + (size_t)(b * 2 + kvh) * T * 64;
    const bf16* Vt = (const bf16*)(F.ws + WS_HEADS + HD_VTB) + (size_t)(b * 2 + kvh) * 64 * T;
    const int t0 = qt * 32;
    bf16x8 qr[4]; load_q<4>(qr, Qh, t0, r32, hi);
    float m = -1e30f, l = 0.f; f32x16 o[2];
#pragma unroll
    for (int dt = 0; dt < 2; ++dt)
#pragma unroll
        for (int r = 0; r < 16; ++r) o[dt][r] = 0.f;
    bf16x8 k0[4], k1[4], k2[4], k3[4], k4[4];
    if (t0 >= 128) {
        load_k<4>(k0, Kh, t0 - 128, r32, hi); load_k<4>(k1, Kh, t0 - 96, r32, hi); load_k<4>(k2, Kh, t0 - 64, r32, hi); load_k<4>(k3, Kh, t0 - 32, r32, hi); load_k<4>(k4, Kh, t0, r32, hi);
        flash_step<4, 2, true, 2, 0>(k0, k1, Vt, T, t0 - 128, t0 - 96, qr, 0.f, m, l, o, r32, hi);
        flash_step<4, 2, true, 0, 0>(k2, k3, Vt, T, t0 - 64, t0 - 32, qr, 0.f, m, l, o, r32, hi);
        flash_step<4, 2, false, 1, 0>(k4, k4, Vt, T, t0, 0, qr, 0.f, m, l, o, r32, hi);
    } else {
        for (int key0 = 0; key0 < t0; key0 += 32) { load_k<4>(k0, Kh, key0, r32, hi); flash_step<4, 2, false, 0, 0>(k0, k0, Vt, T, key0, 0, qr, 0.f, m, l, o, r32, hi); }
        load_k<4>(k4, Kh, t0, r32, hi); flash_step<4, 2, false, 1, 0>(k4, k4, Vt, T, t0, 0, qr, 0.f, m, l, o, r32, hi);
    }
    l = xhalf_sum(l) + fast_exp2(sinks[hq] * LOG2E - m);
    bf16* Orow = (bf16*)(F.ws + WS_O) + (size_t)(b * T + t0 + r32) * D + O_B + hq * 64;
    store_o<2>(Orow, o, fast_rcp(l), hi);
}
__device__ __forceinline__ void sb_item(const Frame& F, int b, int h, int qt) {
    const int lane = F.lane, r32 = lane & 31, hi = lane >> 5, r32p = pi32(r32);
    const bf16* Qh = (const bf16*)(F.ws + WS_HEADS + HD_QC) + (size_t)(b * 4 + h) * T * 64;
    const bf16* Kh = (const bf16*)(F.ws + WS_HEADS + HD_KC) + (size_t)(b * 4 + h) * T * 64;
    const bf16* Vt = (const bf16*)(F.ws + WS_HEADS + HD_VTC) + (size_t)(b * 4 + h) * 64 * T;
    const int t0 = qt * 32;
    bf16x8 qr[4]; load_q<4>(qr, Qh, t0, r32, hi);
    f32x16 o[2];
#pragma unroll
    for (int dt = 0; dt < 2; ++dt)
#pragma unroll
        for (int r = 0; r < 16; ++r) o[dt][r] = 0.f;
    float carry = 1.0f;
    for (int key0 = t0; key0 >= 0; key0 -= 32) {
        f32x16 s = qk_tile<4>(Kh, key0, qr, r32, hi);
        float beta[16], keep[16];
#pragma unroll
        for (int r = 0; r < 16; ++r) { beta[r] = fast_rcp(1.0f + fast_exp2(-s[r])); }
        if (key0 == t0) {
#pragma unroll
            for (int r = 0; r < 16; ++r) if (KEY_OF(r, hi) >= r32) beta[r] = 0.f; }
#pragma unroll
        for (int r = 0; r < 16; ++r) keep[r] = 1.0f - beta[r];
        float sufA[8], sufB[8];
        sufA[7] = 1.f; sufB[7] = 1.f;
#pragma unroll
        for (int i = 6; i >= 0; --i) { sufA[i] = sufA[i + 1] * keep[i + 1]; sufB[i] = sufB[i + 1] * keep[8 + i + 1]; }
        const float PA = sufA[0] * keep[0], PB = sufB[0] * keep[8];
        auto ra = __builtin_amdgcn_permlane32_swap(__float_as_uint(PA), __float_as_uint(PA), false, false);
        auto rb = __builtin_amdgcn_permlane32_swap(__float_as_uint(PB), __float_as_uint(PB), false, false);
        const float PA_lo = __uint_as_float(ra[0]), PA_hi = __uint_as_float(ra[1]), PB_lo = __uint_as_float(rb[0]), PB_hi = __uint_as_float(rb[1]);
        const float tB = PB_lo * PB_hi;
        const float multA = carry * tB * (hi ? 1.0f : PA_hi);
        const float multB = carry * (hi ? 1.0f : PB_hi);
#pragma unroll
        for (int i = 0; i < 8; ++i) { s[i] = beta[i] * sufA[i] * multA; s[8 + i] = beta[8 + i] * sufB[i] * multB; }
        carry *= PA_lo * PA_hi * tB;
        const bf16x8 p0 = pack8(s, 0), p1 = pack8(s, 8);
        pv_tile<2>(Vt, T, key0, p0, p1, o, r32, hi);
        if (__builtin_amdgcn_ballot_w64(carry > 9.0e-13f) == 0ull) break;
    }
    bf16* Orow = (bf16*)(F.ws + WS_O) + (size_t)(b * T + t0 + r32) * D + O_C + h * 64;
    store_o<2>(Orow, o, 1.0f, hi);
}
__device__ __forceinline__ void cross_item(const Frame& F, int l, int b, int hx, int qt) {
    const int lane = F.lane, r32 = lane & 31, hi = lane >> 5, r32p = pi32(r32);
    const bf16* Qh = (const bf16*)(F.ws + WS_QX) + (size_t)(b * 4 + hx) * T * 128;
    const bf16* Kh = (const bf16*)(F.ws + WS_KX) + (size_t)((l * NB + b) * 4 + hx) * 256 * 128;
    const bf16* Vt = (const bf16*)(F.ws + WS_VTX) + (size_t)((l * NB + b) * 4 + hx) * 128 * 256;
    const int t0 = qt * 32;
    bf16x8 qr[8]; load_q<8>(qr, Qh, t0, r32, hi);
    float m = -1e30f, lsum = 0.f; f32x16 o[4];
#pragma unroll
    for (int dt = 0; dt < 4; ++dt)
#pragma unroll
        for (int r = 0; r < 16; ++r) o[dt][r] = 0.f;
    bf16x8 kfa[8], kna[8];
    load_k<8>(kfa, Kh, 0, r32, hi);
    for (int kt = 0; kt < 8; ++kt) {
        if (kt + 1 < 8) load_k<8>(kna, Kh, 32 * (kt + 1), r32, hi);
        flash_step<8, 4, false, 0, 0>(kfa, kfa, Vt, 256, 32 * kt, 0, qr, 0.f, m, lsum, o, r32, hi);
        COPY_K(kfa, kna, 8);
    }
    lsum = xhalf_sum(lsum);
    bf16* Orow = (bf16*)(F.ws + WS_OX) + (size_t)(b * T + t0 + r32) * 512 + hx * 128;
    store_o<4>(Orow, o, fast_rcp(lsum), hi);
}
__device__ __forceinline__ void kmean_phase(const Frame& F, float* kmean) {
    LAS float* part = (LAS float*)F.lds;
    for (int vb = blockIdx.x; vb < NB * 4 * 16; vb += F.G) {
        const int blk = vb & 15, bh = vb >> 4;
        const bf16* Kt = (const bf16*)(F.ws + WS_HEADS + HD_KA) + ((size_t)bh * T + blk * 256 + F.wave * 32) * 64 + (size_t)F.lane * 8;
#pragma unroll
        for (int d0 = 0; d0 < 4; ++d0) { const u32x4 w = *(const GAS u32x4*)(Kt + d0 * 512);
            float a[8] = {bflo(w.x), bfhi(w.x), bflo(w.y), bfhi(w.y), bflo(w.z), bfhi(w.z), bflo(w.w), bfhi(w.w)};
#pragma unroll
            for (int i = 0; i < 8; ++i) { a[i] += __shfl_xor(a[i], 1); a[i] += __shfl_xor(a[i], 2); a[i] += __shfl_xor(a[i], 4); a[i] += __shfl_xor(a[i], 8); a[i] += __shfl_xor(a[i], 16); }
            if ((F.lane & 31) == 0) {
#pragma unroll
                for (int i = 0; i < 8; ++i) part[F.wave * 64 + 16 * d0 + 8 * (F.lane >> 5) + i] = a[i]; } }
        __syncthreads();
        if (F.tid < 64) { float s = 0.f;
#pragma unroll
            for (int w = 0; w < 8; ++w) s += part[w * 64 + F.tid];
            kmean[(size_t)vb * 64 + F.tid] = s * (1.0f / 256.0f); }
        __syncthreads();
    }
}
#ifndef MK_PER_PHASE
#define MK_PER_PHASE 0
#endif
constexpr int CW_BAR = 4096;
constexpr int N_PHASES = 31;
struct KvOrder {
    int G, c;
    __device__ __forceinline__ bool next(int i, Unit& u) const { const int L = i * G + c; if (L >= 32) return false; const int l = L >> 4, rem = L & 15;
        u.pm = l * 4 + (rem >> 2); u.pn = rem & 3; u.pb = l * (int)(WL_SIZE / (256 * 1024 * (KV_I8 ? 1 : 2))) + (rem & 3); u.po = u.pm; return true; }
};
static_assert(WL_SIZE % (256 * 1024 * 2) == 0, "per-layer weight block must be a whole number of 256 x 1024 bf16 tiles");

struct Args { const float* in[23]; float* out; unsigned char* ws; int ph_lo, ph_hi; };
#define RUN() (lo <= ph && ph < hi)
#define SEAM() do { if (lo <= ph && ph + 1 < hi) { for (int _b = 0; _b < REPS(3); ++_b) xcd_barrier(bar, phase_frame(F0).tid); } ++ph; } while (0)
#define wsb (args.ws)
#define x_in (args.in[0])
#define mem (args.in[1])
#define norm_mix (args.in[2])
#define w_in (args.in[3])
#define w_pa (args.in[4])
#define w_pb (args.in[5])
#define w_pc (args.in[6])
#define w_mix (args.in[7])
#define sinks (args.in[8])
#define norm_cross (args.in[9])
#define norm_mem (args.in[10])
#define w_xq (args.in[11])
#define w_xkv (args.in[12])
#define w_xo (args.in[13])
#define norm_ffn (args.in[14])
#define ffn_gate (args.in[15])
#define ffn_up (args.in[16])
#define ffn_down (args.in[17])
#define moe_router (args.in[18])
#define moe_gate (args.in[19])
#define moe_up (args.in[20])
#define moe_down (args.in[21])
#define final_norm (args.in[22])
#define xres ((bf16*)(wsb + WS_XRES))
#define XN ((bf16*)(wsb + WS_XN))
#define ropec ((float*)(wsb + WS_ROPE))
#define ropes ((float*)(wsb + WS_ROPE) + T * 32)
#define kmean ((float*)(wsb + WS_KMEAN))
#define tok_e ((int*)(wsb + WS_ROUTE + RT_TOKE))
#define tok_w ((float*)(wsb + WS_ROUTE + RT_TOKW))
#define tok_slot ((int*)(wsb + WS_ROUTE + RT_SLOT))
#define rowmap ((int*)(wsb + WS_ROUTE + RT_ROWMAP))
#define meta ((int*)(wsb + WS_ROUTE + RT_META))
template <int l> __device__ __forceinline__ void layer_body(const Args& args, const Frame& F0, const XcdBarrier& bar, const int lo, const int hi, int& ph) {
        unsigned char* wl = wsb + WS_W + (size_t)l * WL_SIZE;
        if (RUN()) for (int rep = 0; rep < REPS(4); ++rep) {
            if (l == 0) { const Frame F = phase_frame(F0);
                pg8::Gemm g{(const bf16*)(wsb + WS_MEMN), (const bf16*)(wsb + WS_W + WL_XKV), D, nullptr}; KvOrder S{F.G, (int)((blockIdx.x + F.G - ((INPROJ_I8 && !KV_I8) ? 192 : ((GATE8_LAYERS >> l) & 1) ? 128 : 64)) % F.G)};
                EpiKvMem E{wsb, (const float*)(wsb + WS_ROUTE + RT_RSLOT), (const unsigned*)(wsb + WS_CTL + CTL_CMAX_XKV)};
                pg8::gemm_phase<EpiKvMem, KvOrder, false, true, KV_I8 ? 2 : 0>(F.lds, F.tid, g, S, E); }
            if (INPROJ_I8) { const Frame F = phase_frame(F0);
              pg8::Gemm g{XN, (const bf16*)(wl + WL_IN), D, nullptr}; pg8::StaticOrder S; S.init(M, INW, F.G, (int)blockIdx.x);
              EpiInprojT<true> E{wsb, ropec, ropes, F.lds + RING_BYTES + 1024, (const float*)(wsb + WS_ROUTE + RT_RTOK), (const unsigned*)(wsb + WS_CTL + CTL_CMAX_IN) + l * INW};
              pg8::gemm_phase<EpiInprojT<true>, pg8::StaticOrder, false, true, 2>(F.lds, F.tid, g, S, E); }
            else { const Frame F = phase_frame(F0);
              pg8::Gemm g{XN, (const bf16*)(wl + WL_IN), D, nullptr}; pg8::StaticOrder S; S.init(M, ((GATE8_LAYERS >> l) & 1) ? 2304 : INW, F.G, (int)blockIdx.x); EpiInproj E{wsb, ropec, ropes, F.lds + RING_BYTES + 1024};
              pg8::gemm_phase<EpiInproj, pg8::StaticOrder>(F.lds, F.tid, g, S, E); }
            if ((GATE8_LAYERS >> l) & 1) { const Frame F = phase_frame(F0);
              pg8::Gemm g{(const bf16*)(wsb + WS_XN8), (const bf16*)(wl + WL_IN + WL_IN_G8), D, nullptr}; GateOrder S; S.init(F.G, (int)blockIdx.x, 64); EpiGates8 E{wsb};
              pg8::gemm_phase<EpiGates8, GateOrder, false, true, true>(F.lds, F.tid, g, S, E); }
        }
        SEAM();
        if (RUN()) for (int rep = 0; rep < REPS(6); ++rep) { const Frame F = phase_frame(F0); kmean_phase(F, kmean); }
        SEAM();
        if (RUN()) for (int rep = 0; rep < REPS(1); ++rep) {
            const Frame F = phase_frame(F0);
            for (int vb0 = blockIdx.x; vb0 < 256; vb0 += F.G) {
                const int xc = vb0 & 7, yc = vb0 >> 3; const int vb = ((2 * xc + (yc & 1)) << 4) | (yc >> 1), vbs = xc * 32 + yc;
                { const int bh = vb >> 4, r = vb & 15, j = r >> 1, half = r & 1; const int ob = (F.wave < 4) ? j : 15 - j; const int qt = ob * 8 + half * 4 + (F.wave & 3);
                  if (MOBA_LDS) moba_wg(F, bh >> 2, bh & 3, qt, ((((15 - j) * 8 + half * 4 + 3) >> 1) + 1), kmean); else moba_item(F, bh >> 2, bh & 3, qt, kmean); }
#pragma unroll 1
                for (int k = 0; k < 2; ++k) { const int item = 16 * vbs + 8 * k + F.wave; const int bh = item >> 7; swa_item(F, bh >> 3, bh & 7, item & 127, sinks + l * 8); }
                { const int item = 8 * vb + F.wave; const int bh = item >> 7; sb_item(F, bh >> 2, bh & 3, item & 127); }
            }
        }
        SEAM();
        if (RUN()) for (int rep = 0; rep < REPS(5); ++rep) {
            const Frame F = phase_frame(F0);
            pg8::Gemm g{(const bf16*)(wsb + WS_O), (const bf16*)(wl + WL_PA), D, nullptr}; pg8::StaticOrder S; S.init(M, D, F.G, (int)blockIdx.x);
            EpiGateMix E{(const bf16*)(wsb + WS_G), (bf16*)(wsb + WS_UBF)}; pg8::gemm_phase<EpiGateMix, pg8::StaticOrder>(F.lds, F.tid, g, S, E);
        }
        SEAM();
        if (RUN()) { const Frame F = phase_frame(F0); pg8::Gemm g{(const bf16*)(wsb + WS_UBF), (const bf16*)(wl + WL_MIX), D, nullptr}; pg8::StaticOrder S; S.init(M, D, F.G, (int)blockIdx.x);
            EpiResid<l == 0> E{x_in, xres, xres}; pg8::gemm_phase<EpiResid<l == 0>, pg8::StaticOrder>(F.lds, F.tid, g, S, E); }
        SEAM();
        if (RUN()) for (int rep = 0; rep < REPS(2); ++rep) { const Frame F = phase_frame(F0); if (XQ8) norm_rows<false, true, true, true>(F, xres, norm_cross + l * D, XN, M, nullptr, nullptr, nullptr); else norm_rows<false>(F, xres, norm_cross + l * D, XN, M, nullptr, nullptr, nullptr); }
        SEAM();
        if (RUN()) { const Frame F = phase_frame(F0); pg8::Gemm g{XN, (const bf16*)(wl + WL_XQ), D, nullptr}; pg8::StaticOrder S; S.init(M, XW, F.G, (int)blockIdx.x);
            EpiXq E{(bf16*)(wsb + WS_QX), XQ8 ? QSCALE128 * F8_WINV : QSCALE128}; pg8::gemm_phase<EpiXq, pg8::StaticOrder, false, true, XQ8 != 0>(F.lds, F.tid, g, S, E); }
        SEAM();
        if (RUN()) for (int rep = 0; rep < REPS(7); ++rep) {
            const Frame F = phase_frame(F0);
            for (int item = blockIdx.x * NWAVES + F.wave; item < NB * 4 * 128; item += F.G * NWAVES) { const int bh = item >> 7; cross_item(F, l, bh >> 2, bh & 3, item & 127); }
        }
        SEAM();
        if (RUN()) { const Frame F = phase_frame(F0); pg8::Gemm g{(const bf16*)(wsb + WS_OX), (const bf16*)(wl + WL_XO), XW, nullptr}; pg8::StaticOrder S; S.init(M, D, F.G, (int)blockIdx.x);
            EpiResid<false> E{nullptr, xres, xres}; pg8::gemm_phase<EpiResid<false>, pg8::StaticOrder>(F.lds, F.tid, g, S, E); }
        SEAM();
        if (l == 0) {
            if (RUN()) for (int rep = 0; rep < REPS(2); ++rep) { const Frame F = phase_frame(F0); norm_rows<false, true, true, 2>(F, xres, norm_ffn, XN, M, nullptr, nullptr, nullptr, nullptr, nullptr, (float*)(wsb + WS_ROUTE + RT_RTOK)); }
            SEAM();
            if (RUN()) for (int rep = 0; rep < REPS(9); ++rep) { const Frame F = phase_frame(F0); pg8::Gemm g{XN, (const bf16*)(wsb + WS_FFN_GU), D, nullptr}; pg8::StaticOrder S; S.init(M, 2 * DFF, F.G, (int)blockIdx.x);
                EpiSwigluI8 E{(bf16*)(wsb + WS_HFFN), HFFN_LD, (const float*)(wsb + WS_ROUTE + RT_RTOK), (const unsigned*)(wsb + WS_CTL + CTL_CMAX)}; pg8::gemm_phase<EpiSwigluI8, pg8::StaticOrder, false, true, 2>(F.lds, F.tid, g, S, E); }
            SEAM();
            if (RUN()) for (int rep = 0; rep < REPS(12); ++rep) { const Frame F = phase_frame(F0); pg8::Gemm g{(const bf16*)(wsb + WS_HFFN), (const bf16*)(wsb + WS_FFN_DN), DFF, nullptr, HFFN_LD, HFFN_LD}; pg8::StaticOrder S; S.init(M, D, F.G, (int)blockIdx.x);
                EpiResid<false> E{nullptr, xres, (rep + 1 < REPS(12)) ? (bf16*)(wsb + WS_G + 32 * MiB) : xres}; pg8::gemm_phase<EpiResid<false>, pg8::StaticOrder>(F.lds, F.tid, g, S, E); }
            SEAM();
            if (RUN()) for (int rep = 0; rep < REPS(2); ++rep) { const Frame F = phase_frame(F0); if (INPROJ_I8) norm_rows<false, true, true, 2>(F, xres, norm_mix + D, XN, M, nullptr, nullptr, nullptr, nullptr, nullptr, (float*)(wsb + WS_ROUTE + RT_RTOK));
                else if (GATE8_LAYERS & 2) norm_rows<false, true, true, false, true>(F, xres, norm_mix + D, XN, M, nullptr, nullptr, nullptr, nullptr, wsb + WS_XN8); else norm_rows<false>(F, xres, norm_mix + D, XN, M, nullptr, nullptr, nullptr); }
            SEAM();
        } else {
            if (RUN()) { const Frame F = phase_frame(F0); norm_rows<true, true, true, true>(F, xres, norm_ffn + D, XN, M, moe_router, tok_e, tok_w); }
            SEAM();
            if (RUN()) { const Frame F = phase_frame(F0); if (blockIdx.x == 0) moe_route(F, tok_e, tok_slot, rowmap, meta); }
            SEAM();
            const bool any_moe = (lo <= ph + 3 && ph < hi);
            const int RT = any_moe ? meta[0] : 0;
            const int n0c = RT < MOE_CHUNK_RT ? RT : MOE_CHUNK_RT, rem = RT - n0c, X = (rem > MOE_CHUNK_RT) ? MOE_X : 0, n1 = rem - X;
            if (RUN()) for (int rep = 0; rep < REPS(10); ++rep) { const Frame F = phase_frame(F0); pg8::Gemm g{XN, (const bf16*)(wsb + WS_MOE_GU), D, rowmap}; pg8::MoeOrder<true> S; S.init(n0c + X, 2 * DFE, F.G, (int)blockIdx.x, n0c, 0, n0c + n1, 0, 0, meta + 16);
                EpiSwiglu8 E{wsb + WS_HMOE, DFE}; pg8::gemm_phase<EpiSwiglu8, pg8::MoeOrder<true>, true, true, true>(F.lds, F.tid, g, S, E); }
            SEAM();
            if (RUN()) { const Frame F = phase_frame(F0); pg8::Gemm g{(const bf16*)(wsb + WS_HMOE), (const bf16*)(wsb + WS_MOE_DN), DFE, nullptr}; pg8::MoeOrder<false> S; S.init(n0c, D, F.G, (int)blockIdx.x, n0c, 0, 0, 0, 0, meta + 16);
                EpiBf16Out E{(bf16*)(wsb + WS_Y), D, F8_WINV}; pg8::gemm_phase<EpiBf16Out, pg8::MoeOrder<false>, false, true, true>(F.lds, F.tid, g, S, E); }
            SEAM();
            if (RUN()) {
                { const Frame F = phase_frame(F0); pg8::Gemm g{(const bf16*)(wsb + WS_HMOE), (const bf16*)(wsb + WS_MOE_DN), DFE, nullptr}; pg8::MoeOrder<false> S; S.init(X, D, F.G, (int)blockIdx.x, X, n0c + n1, 0, n0c, 0, meta + 16);
                  EpiBf16Out E{(bf16*)(wsb + WS_Y), D, F8_WINV}; pg8::gemm_phase<EpiBf16Out, pg8::MoeOrder<false>, false, true, true>(F.lds, F.tid, g, S, E); }
                { const Frame F = phase_frame(F0); pg8::Gemm g{XN, (const bf16*)(wsb + WS_MOE_GU), D, rowmap}; pg8::MoeOrder<true> S; S.init(n1, 2 * DFE, F.G, (int)blockIdx.x, n1, n0c, 0, 0, 4 * X, meta + 16);
                  EpiSwiglu8 E{wsb + WS_HMOE, DFE}; pg8::gemm_phase<EpiSwiglu8, pg8::MoeOrder<true>, true, true, true>(F.lds, F.tid, g, S, E); }
            }
            SEAM();
            if (RUN()) { const Frame F = phase_frame(F0); pg8::Gemm g{(const bf16*)(wsb + WS_HMOE), (const bf16*)(wsb + WS_MOE_DN), DFE, nullptr}; pg8::MoeOrder<false> S; S.init(n1, D, F.G, (int)blockIdx.x, n1, n0c, 0, 0, 0, meta + 16);
                EpiBf16Out E{(bf16*)(wsb + WS_Y), D, F8_WINV}; pg8::gemm_phase<EpiBf16Out, pg8::MoeOrder<false>, false, true, true>(F.lds, F.tid, g, S, E); }
            SEAM();
            if (RUN()) { const Frame F = phase_frame(F0); combine_final(F, xres, (const bf16*)(wsb + WS_Y), tok_slot, tok_w, final_norm, args.out); }
            SEAM();
        }
}
__global__ void __launch_bounds__(NWAVES * 64, 2) mk_fwd(Args args) {
    extern __shared__ __attribute__((aligned(16))) unsigned char lds_raw[];
    Frame F0;
    F0.lds = (LAS unsigned char*)lds_raw;
    { const int t0 = threadIdx.x; F0.tid = 0; F0.lane = 0; F0.wave = __builtin_amdgcn_readfirstlane(t0 >> 6); F0.G = gridDim.x; F0.ws = args.ws;
      for (int u = t0; u < (LDS_BYTES - RING_BYTES) / 4; u += NWAVES * 64) ((LAS unsigned*)(F0.lds + RING_BYTES))[u] = 0u; }
    volatile LAS unsigned* MISC = (volatile LAS unsigned*)(F0.lds + MISC_OFF);
    __syncthreads();
    unsigned* ctl = (unsigned*)(args.ws + WS_CTL);
    XcdBarrier bar = xcd_barrier_post(ctl + CW_BAR, MISC + 8, phase_frame(F0).tid);
    const int lo = args.ph_lo, hi = args.ph_hi;
    int ph = 0;
    if (RUN()) { const Frame F = phase_frame(F0); int rot = 0; colmax_matrix<2>(F, rot, ffn_gate, ffn_up, DFF, D, 2 * DFF, (unsigned*)(wsb + WS_CTL + CTL_CMAX));
        if (INPROJ_I8) for (int l = 0; l < 2; ++l) colmax_matrix<1>(F, rot, w_in + (size_t)l * D * INW, nullptr, INW, D, INW, (unsigned*)(wsb + WS_CTL + CTL_CMAX_IN) + l * INW);
        if (KV_I8) for (int l = 0; l < 2; ++l) colmax_matrix<0>(F, rot, w_xkv + (size_t)l * D * 2 * XW, nullptr, 2 * XW, D, 2 * XW, (unsigned*)(wsb + WS_CTL + CTL_CMAX_XKV) + l * 2 * XW); }
    SEAM();
    if (RUN()) for (int rep = 0; rep < REPS(0); ++rep) {
        const Frame F = phase_frame(F0);
        LAS float* scr = (LAS float*)(F.lds + F.wave * 16896);
        LAS float* scr8 = scr;
        { const int gt = blockIdx.x * (NWAVES * 64) + F.tid, NT = F.G * NWAVES * 64;
          for (int idx = gt; idx < T * 32; idx += NT) { const int pos = idx >> 5, i = idx & 31; const float inv = powf(10000.0f, -(float)i / 32.0f); const float ang = (float)pos * inv;
              ropec[idx] = cosf(ang); ropes[idx] = sinf(ang); } }
        int rot = 0;
        transpose_matrix<2, 2>(F, rot, ffn_gate, ffn_up, DFF, D, 2 * DFF, (bf16*)(wsb + WS_FFN_GU), scr, 0, (const unsigned*)(wsb + WS_CTL + CTL_CMAX));
        if (INPROJ_I8) for (int l = 0; l < 2; ++l) transpose_matrix<1, 2>(F, rot, w_in + (size_t)l * D * INW, nullptr, INW, D, INW, (bf16*)(wsb + WS_W + (size_t)l * WL_SIZE + WL_IN), scr, 0, (const unsigned*)(wsb + WS_CTL + CTL_CMAX_IN) + l * INW);
        for (int e = 0; e < NE; ++e) {
            transpose_matrix_f8<2>(F, rot, moe_gate + (size_t)e * D * DFE, moe_up + (size_t)e * D * DFE, DFE, D, 2 * DFE, wsb + WS_MOE_GU + (size_t)e * 2 * DFE * D, scr8, D);
            transpose_matrix_f8<0>(F, rot, moe_down + (size_t)e * DFE * D, nullptr, D, DFE, D, wsb + WS_MOE_DN + (size_t)e * D * DFE, scr8, DFE);
        }
        transpose_matrix<0>(F, rot, ffn_down, nullptr, D, DFF, D, (bf16*)(wsb + WS_FFN_DN), scr, HFFN_LD);
        for (int l = 0; l < 2; ++l) {
            unsigned char* wl = wsb + WS_W + (size_t)l * WL_SIZE;
            if (INPROJ_I8) { }
            else if ((GATE8_LAYERS >> l) & 1) { transpose_matrix<1>(F, rot, w_in + (size_t)l * D * INW, nullptr, INW, D, 2304, (bf16*)(wl + WL_IN), scr);
                transpose_matrix<0, true>(F, rot, w_in + (size_t)l * D * INW + 2304, nullptr, INW, D, 3072, (bf16*)(wl + WL_IN + WL_IN_G8), scr); }
            else transpose_matrix<1>(F, rot, w_in + (size_t)l * D * INW, nullptr, INW, D, INW, (bf16*)(wl + WL_IN), scr);
            transpose_matrix<0>(F, rot, w_pa + (size_t)l * 256 * D, nullptr, D, 256, D, (bf16*)(wl + WL_PA), scr, D);
            transpose_matrix<0>(F, rot, w_pb + (size_t)l * 512 * D, nullptr, D, 512, D, (bf16*)(wl + WL_PA) + 256, scr, D);
            transpose_matrix<0>(F, rot, w_pc + (size_t)l * 256 * D, nullptr, D, 256, D, (bf16*)(wl + WL_PA) + 768, scr, D);
            transpose_matrix<0>(F, rot, w_mix + (size_t)l * D * D, nullptr, D, D, D, (bf16*)(wl + WL_MIX), scr);
            transpose_matrix<0, XQ8 != 0>(F, rot, w_xq + (size_t)l * D * XW, nullptr, XW, D, XW, (bf16*)(wl + WL_XQ), scr);
            transpose_matrix<0, KV_I8 ? 2 : 0>(F, rot, w_xkv + (size_t)l * D * 2 * XW, nullptr, 2 * XW, D, 2 * XW, (bf16*)(wl + WL_XKV), scr, 0, (const unsigned*)(wsb + WS_CTL + CTL_CMAX_XKV) + l * 2 * XW);
            transpose_matrix<0>(F, rot, w_xo + (size_t)l * XW * D, nullptr, D, XW, D, (bf16*)(wl + WL_XO), scr);
            if (KV_I8) norm_rows<false, false, true, 2>(F, mem, norm_mem + l * D, (bf16*)(wsb + WS_MEMN + (size_t)l * NB * MEML * D), NB * MEML, nullptr, nullptr, nullptr, nullptr, nullptr, (float*)(wsb + WS_ROUTE + RT_RSLOT) + l * NB * MEML);
            else norm_rows<false, false>(F, mem, norm_mem + l * D, (bf16*)(wsb + WS_MEMN) + (size_t)l * NB * MEML * D, NB * MEML, nullptr, nullptr, nullptr);
        }
        if (INPROJ_I8) norm_rows<false, false, true, 2>(F, x_in, norm_mix, XN, M, nullptr, nullptr, nullptr, nullptr, nullptr, (float*)(wsb + WS_ROUTE + RT_RTOK));
        else if (GATE8_LAYERS & 1) norm_rows<false, false, true, false, true>(F, x_in, norm_mix, XN, M, nullptr, nullptr, nullptr, nullptr, wsb + WS_XN8); else norm_rows<false, false>(F, x_in, norm_mix, XN, M, nullptr, nullptr, nullptr);
    }
    SEAM();

    layer_body<0>(args, F0, bar, lo, hi, ph);
    layer_body<1>(args, F0, bar, lo, hi, ph);
#undef RUN
#undef SEAM
}
#undef wsb
#undef x_in
#undef mem
#undef xres
#undef XN
#undef ropec
#undef ropes
#undef kmean
#undef tok_e
#undef tok_w
#undef tok_slot
#undef rowmap
#undef meta
#undef sinks
#undef norm_mix
#undef w_in
#undef w_pa
#undef w_pb
#undef w_pc
#undef w_mix
#undef norm_cross
#undef norm_mem
#undef w_xq
#undef w_xkv
#undef w_xo
#undef norm_ffn
#undef ffn_gate
#undef ffn_up
#undef ffn_down
#undef moe_router
#undef moe_gate
#undef moe_up
#undef moe_down
#undef final_norm

extern "C" void kernel_launch(void* const* d_in, const int* in_sizes, int n_in, void* d_out, int out_size, void* d_ws, size_t ws_size, hipStream_t stream) {
    static int grid = 0;
    if (grid == 0) {
        if (n_in != 23 || in_sizes[0] != M * D || out_size != M * D || ws_size < WS_END) { fprintf(stderr, "kernel_launch: unexpected shapes / workspace (n_in %d, wsb %zu < %zu); nothing launched\n", n_in, ws_size, (size_t)WS_END); grid = -1; return; }
        int dev = 0, cus = 0, per_cu = 0;
        if (hipGetDevice(&dev) != hipSuccess || hipDeviceGetAttribute(&cus, hipDeviceAttributeMultiprocessorCount, dev) != hipSuccess) { grid = -1; return; }
        if (hipFuncSetAttribute((const void*)mk_fwd, hipFuncAttributeMaxDynamicSharedMemorySize, LDS_BYTES) != hipSuccess) { fprintf(stderr, "kernel_launch: hipFuncSetAttribute failed\n"); grid = -1; return; }
        if (hipOccupancyMaxActiveBlocksPerMultiprocessor(&per_cu, (const void*)mk_fwd, NWAVES * 64, LDS_BYTES) != hipSuccess || per_cu < 1)
            fprintf(stderr, "kernel_launch: note: occupancy query reports %d workgroups per CU\n", per_cu);
        (void)hipGetLastError();
        grid = cus;
    }
    if (grid < 0) return;
    if (hipMemsetAsync((char*)d_ws + WS_CTL, 0, CTL_ZERO_BYTES, stream) != hipSuccess) return;
    Args a{};
    for (int i = 0; i < 23; ++i) a.in[i] = (const float*)d_in[i];
    a.out = (float*)d_out; a.ws = (unsigned char*)d_ws;
#if MK_PER_PHASE
    for (int k = 0; k < N_PHASES; ++k) { a.ph_lo = k; a.ph_hi = k + 1; hipLaunchKernelGGL(mk_fwd, dim3(grid), dim3(NWAVES * 64), LDS_BYTES, stream, a); }
#else
    a.ph_lo = 0; a.ph_hi = N_PHASES; hipLaunchKernelGGL(mk_fwd, dim3(grid), dim3(NWAVES * 64), LDS_BYTES, stream, a);
#endif
}
```

```cpp
#include <hip/hip_runtime.h>
#include <cstdio>
#include <cstdint>
#include <cmath>

#ifndef PROBE_DOUBLE
#define PROBE_DOUBLE 0
#endif
#define REPS(bit) (1 + ((PROBE_DOUBLE >> (bit)) & 1))
#ifndef XQ8
#define XQ8 1
#endif
#ifndef MOBA_LDS
#define MOBA_LDS 0
#endif
#ifndef INPROJ_I8
#define INPROJ_I8 1
#endif
#ifndef GATE8_LAYERS
#define GATE8_LAYERS (INPROJ_I8 ? 0 : 3)
#endif
#define LAS __attribute__((address_space(3)))
#define GAS __attribute__((address_space(1)))
typedef unsigned short bf16;
typedef short bf16x8 __attribute__((ext_vector_type(8)));
typedef float f32x4 __attribute__((ext_vector_type(4)));
typedef float f32x2 __attribute__((ext_vector_type(2)));
typedef float f32x16 __attribute__((ext_vector_type(16)));
typedef unsigned u32x4 __attribute__((ext_vector_type(4)));
typedef unsigned u32x2 __attribute__((ext_vector_type(2)));
typedef int i32x8 __attribute__((ext_vector_type(8)));
typedef int i32x4 __attribute__((ext_vector_type(4)));

constexpr int NB = 4, T = 4096, M = NB * T, D = 1024, INW = 5376;
constexpr int MEML = 256, XW = 512, DFF = 2816, NE = 8, DFE = 3584;
constexpr float EPS = 1e-6f;
constexpr float LOG2E = 1.4426950408889634f;
constexpr float QSCALE64 = 0.125f * LOG2E;
constexpr float QSCALE128 = 0.08838834764831845f * LOG2E;

typedef __bf16 bf16x2_t __attribute__((ext_vector_type(2)));
__device__ __forceinline__ unsigned cvt_pk_bf16(float lo, float hi) { f32x2 v = {lo, hi}; bf16x2_t b = __builtin_convertvector(v, bf16x2_t); return __builtin_bit_cast(unsigned, b); }
__device__ __forceinline__ float bf2f(unsigned short b) { return __uint_as_float((unsigned)b << 16); }
__device__ __forceinline__ float bflo(unsigned w) { return __uint_as_float(w << 16); }
__device__ __forceinline__ float bfhi(unsigned w) { return __uint_as_float(w & 0xffff0000u); }
__device__ __forceinline__ float fast_exp2(float x) { return __builtin_amdgcn_exp2f(x); }
__device__ __forceinline__ float fast_rcp(float x) { return __builtin_amdgcn_rcpf(x); }
__device__ __forceinline__ float sigmoidf_fast(float x) { return fast_rcp(1.0f + fast_exp2(-x * LOG2E)); }

constexpr float F8_WSCALE = 64.0f, F8_WINV = 1.0f / 64.0f;
__device__ __forceinline__ float f8clamp(float v) { return __builtin_amdgcn_fmed3f(v, -448.f, 448.f); }
__device__ __forceinline__ unsigned cvt_pk4_fp8(float a, float b, float c, float d) {
    int p = __builtin_amdgcn_cvt_pk_fp8_f32(f8clamp(a), f8clamp(b), 0, false); p = __builtin_amdgcn_cvt_pk_fp8_f32(f8clamp(c), f8clamp(d), p, true); return (unsigned)p; }
__device__ __forceinline__ void st16(void* p, u32x4 v) { *(GAS u32x4*)p = v; }
__device__ __forceinline__ void st16(void* p, f32x4 v) { *(GAS f32x4*)p = v; }
__device__ __forceinline__ void st8(void* p, u32x2 v) { *(GAS u32x2*)p = v; }

namespace pg8 {
constexpr int BM = 256, BK = 64, HALF = 128, HTB = HALF * BK * 2, STAGE_BYTES = 8 * HTB, NXCD = 8, WGM = 8;
__host__ __device__ __forceinline__ int lds_byte(int r, int c) { const int st = (r >> 4) * 2 + (c >> 5), rr = r & 15, cc = c & 31, ob = rr * 64 + cc * 2; return st * 1024 + (ob ^ (((ob >> 9) & 1) << 5)); }
__host__ __device__ __forceinline__ void stage_rc(int b, int& R, int& C) { const int st = b / 1024, sb = b % 1024, swz = sb ^ (((sb >> 9) & 1) << 5); R = (st >> 1) * 16 + swz / 64; C = (st & 1) * 32 + (swz % 64) / 2; }
__host__ __device__ __forceinline__ int perm32(int rho) { const int n = rho >> 4, i = rho & 15; return 8 * (i >> 2) + 4 * n + (i & 3); }

struct Unit { int pm, pn, pb, po; };
struct Gemm { const bf16* A; const bf16* Bt; int K; const int* rowmap; int lda = 0, ldb = 0; };

struct StaticOrder {
    int nM, nN, nwg, G, c;
    __device__ void init(int M_, int N_, int G_, int c_) { nM = M_ / BM; nN = N_ / BM; nwg = nM * nN; G = G_; c = c_; }
    __device__ __forceinline__ bool next_mn(int i, int& pm, int& pn) const { return next_L((long)i * G + c, pm, pn); }
    __device__ __forceinline__ bool next_L(long L, int& pm, int& pn) const {
        if (L >= nwg) return false;
        int wgid = (int)L; { const int q = nwg / NXCD, r = nwg % NXCD, xcd = wgid % NXCD, off = wgid / NXCD; wgid = (xcd < r ? xcd * (q + 1) : r * (q + 1) + (xcd - r) * q) + off; }
        const int nig = WGM * nN, gid = wgid / nig, fm = gid * WGM, gsz = (nM - fm) < WGM ? (nM - fm) : WGM;
        pm = fm + ((wgid % nig) % gsz); pn = (wgid % nig) / gsz; return true;
    }
    __device__ __forceinline__ bool next(int i, Unit& u) const { int pm, pn; if (!next_mn(i, pm, pn)) return false; u.pm = pm; u.pn = pn; u.pb = pn; u.po = pm; return true; }
};
template <bool UP> struct MoeOrder {
    StaticOrder so; int n0, rtA, rtB, hbase, nd; const int* tile_expert; int nNexp;
    __device__ void init(int ntiles, int N_, int G_, int c_, int n0_, int rtA_, int rtB_, int hbase_, int nd_, const int* te) { so.init(ntiles * BM, N_, G_, c_); n0 = n0_; rtA = rtA_; rtB = rtB_; hbase = hbase_; nd = nd_; tile_expert = te; nNexp = N_ / BM; }
    __device__ __forceinline__ bool next(int i, Unit& u) const {
        long L;
        if (nd == 0) L = (long)i * so.G + so.c;
        else { const int r = (so.c < nd) ? i + 3 : i; if (r < 3) L = (long)r * (so.G - nd) + (so.c - nd); else L = 3L * (so.G - nd) + (long)(r - 3) * so.G + so.c; }
        int pm, pn; if (!so.next_L(L, pm, pn)) return false;
        const int rt = pm < n0 ? rtA + pm : rtB + (pm - n0); const int e = __builtin_amdgcn_readfirstlane(tile_expert[rt]);
        u.pn = pn; u.pb = e * nNexp + pn; if (UP) { u.pm = rt; u.po = hbase + pm; } else { u.pm = hbase + pm; u.po = rt; } return true; }
};

template <class Epi, class Sched, bool GATHER = false, bool ALIGN_EPI = true, int MODE = 0>
__device__ __forceinline__ void gemm_phase(LAS unsigned char* lds, const int tid  , const Gemm g, const Sched& S, const Epi& E) {
    const int wid = __builtin_amdgcn_readfirstlane(tid >> 6), lane = tid & 63, wr = wid >> 2, wc = wid & 3, fr = lane & 15, fq = lane >> 4;
    constexpr bool F8 = (MODE == 1), I8 = (MODE == 2);
    constexpr int EB = MODE ? 1 : 2;
    const int K = g.K, nt = K / (MODE ? 2 * BK : BK), lda = (g.lda ? g.lda : K) * EB, ldb = (g.ldb ? g.ldb : K) * EB;
    unsigned voffA[2], voffB[2];
#pragma unroll
    for (int i = 0; i < 2; ++i) { int R, C; stage_rc(tid * 16 + i * 8192, R, C); const int Rb = Epi::PERM ? ((R & ~31) + perm32(R & 31)) : R; voffA[i] = (unsigned)(R * lda + C * 2); voffB[i] = (unsigned)(Rb * ldb + C * 2); }
    const size_t kstep = (size_t)(BK * 2);
    const size_t hstepA = (size_t)HALF * lda, hstep = (size_t)HALF * ldb;
    const size_t tstepA = 2 * hstepA, tstep = 2 * hstep;
    const unsigned ldsw = (unsigned)wid * 1024u;
    const int aoff = lds_byte(wr * 64 + fr, fq * 8), boff = lds_byte(wc * 32 + fr, fq * 8);
#define PG8_SA(b, h) (((b) * 2 + (h)) * HTB)
#define PG8_SB(b, h) ((4 + (b) * 2 + (h)) * HTB)
#define PG8_STAGE(bufoff, gbase, voff) do { _Pragma("unroll") for (int _i = 0; _i < 2; ++_i) \
        __builtin_amdgcn_global_load_lds((const unsigned*)((const char*)(gbase) + (voff)[_i]), (LAS unsigned*)(lds + (bufoff) + ldsw + _i * 8192), 16, 0, 0); } while (0)
#define PG8_LDA(dst, b, h) do { _Pragma("unroll") for (int m = 0; m < 4; ++m) { if constexpr (F8) { dst##8[m].lo = *(const LAS i32x4*)(lds + PG8_SA(b, h) + aoff + m * 2048); dst##8[m].hi = *(const LAS i32x4*)(lds + PG8_SA(b, h) + aoff + m * 2048 + 1024); } \
        else { _Pragma("unroll") for (int k = 0; k < 2; ++k) dst[m][k] = *(const LAS bf16x8*)(lds + PG8_SA(b, h) + aoff + m * 2048 + k * 1024); } } } while (0)
#define PG8_LDB(dst, b, h) do { _Pragma("unroll") for (int n = 0; n < 2; ++n) { if constexpr (F8) { dst##8[n].lo = *(const LAS i32x4*)(lds + PG8_SB(b, h) + boff + n * 2048); dst##8[n].hi = *(const LAS i32x4*)(lds + PG8_SB(b, h) + boff + n * 2048 + 1024); } \
        else { _Pragma("unroll") for (int k = 0; k < 2; ++k) dst[n][k] = *(const LAS bf16x8*)(lds + PG8_SB(b, h) + boff + n * 2048 + k * 1024); } } } while (0)
#define PG8_MMA(ai, bj, At, Bt) do { __builtin_amdgcn_s_setprio(1); _Pragma("unroll") for (int m = 0; m < 4; ++m) _Pragma("unroll") for (int n = 0; n < 2; ++n) { if constexpr (F8) \
        asm volatile("v_mfma_f32_16x16x128_f8f6f4 %0, %1, %2, %0" : "+v"(acc[ai][bj][m][n]) : "v"(Bt##8[n]), "v"(At##8[m])); else if constexpr (I8) { _Pragma("unroll") for (int k = 0; k < 2; ++k) \
        acc[ai][bj][m][n] = __builtin_bit_cast(f32x4, __builtin_amdgcn_mfma_i32_16x16x64_i8(__builtin_bit_cast(i32x4, Bt[n][k]), __builtin_bit_cast(i32x4, At[m][k]), __builtin_bit_cast(i32x4, acc[ai][bj][m][n]), 0, 0, 0)); } else { _Pragma("unroll") for (int k = 0; k < 2; ++k) \
        acc[ai][bj][m][n] = __builtin_amdgcn_mfma_f32_16x16x32_bf16(Bt[n][k], At[m][k], acc[ai][bj][m][n], 0, 0, 0); } } __builtin_amdgcn_s_setprio(0); } while (0)
#define PG8_WAIT_V(n) asm volatile("s_waitcnt vmcnt(" #n ")" ::: "memory")
#define PG8_WAIT_L(n) asm volatile("s_waitcnt lgkmcnt(" #n ")" ::: "memory")
#define PG8_BAR __builtin_amdgcn_s_barrier()
#define PG8_SCHED __builtin_amdgcn_sched_barrier(0)
    LAS int* rmL = (LAS int*)(lds + 131072 + 12288);
#define PG8_RMDMA(b, u) __builtin_amdgcn_global_load_lds((const unsigned*)(g.rowmap + (u).pm * BM + (wid & 3) * 64 + lane), (LAS unsigned*)(rmL + (b) * 256 + (wid & 3) * 64), 4, 0, 0)
#define PG8_GOFFS(vo, b) do { _Pragma("unroll") for (int _h = 0; _h < 2; ++_h) _Pragma("unroll") for (int _i = 0; _i < 2; ++_i) { int _R, _C; stage_rc(tid * 16 + _i * 8192, _R, _C); \
        const int _row = rmL[(b) * 256 + _h * HALF + _R]; vo[_h][_i] = (unsigned)(_row * lda + _C * 2); } } while (0)
#define PG8_STAGE_A(bufoff, p, h, nextu) do { if constexpr (GATHER) { if (nextu) PG8_STAGE(bufoff, p, voN[h]); else PG8_STAGE(bufoff, p, voC[h]); } else PG8_STAGE(bufoff, (p) + (h) * hstepA, voffA); } while (0)
    Unit cur, nxt; int ui = 0;
    if (!S.next(0, cur)) return;
    f32x4 acc[2][2][4][2];
#pragma unroll
    for (int a = 0; a < 2; ++a)
#pragma unroll
        for (int b = 0; b < 2; ++b)
#pragma unroll
            for (int m = 0; m < 4; ++m)
#pragma unroll
                for (int n = 0; n < 2; ++n) acc[a][b][m][n] = (f32x4){0.f, 0.f, 0.f, 0.f};
    bf16x8 At[4][2], B0[2][2], B1[2][2];
    i32x8 At8[4], B08[2], B18[2];
    unsigned voC[2][2], voN[2][2];
    if constexpr (GATHER) { PG8_RMDMA(0, cur); PG8_WAIT_V(0); PG8_BAR; PG8_GOFFS(voC, 0); }
    const char* cA = GATHER ? (const char*)g.A : (const char*)g.A + (size_t)cur.pm * tstepA; const char* cB = (const char*)g.Bt + (size_t)cur.pb * tstep;
    PG8_STAGE(PG8_SB(0, 0), cB, voffB); PG8_STAGE(PG8_SB(0, 1), cB + hstep, voffB); PG8_STAGE_A(PG8_SA(0, 0), cA, 0, false); PG8_STAGE_A(PG8_SA(0, 1), cA, 1, false);
    if (wr == 1) PG8_BAR;
    PG8_WAIT_V(2); PG8_BAR;
    PG8_STAGE(PG8_SB(1, 0), cB + kstep, voffB); PG8_STAGE_A(PG8_SA(1, 0), cA + kstep, 0, false); PG8_STAGE(PG8_SB(1, 1), cB + hstep + kstep, voffB);
    PG8_WAIT_V(6); PG8_BAR;
    for (;;) {
        const bool has_next = S.next(ui + 1, nxt);
        if constexpr (GATHER) { if (has_next) PG8_RMDMA((ui + 1) & 1, nxt); }
        const char* nA = GATHER ? cA : (has_next ? (const char*)g.A + (size_t)nxt.pm * tstepA : cA); const char* nB = has_next ? (const char*)g.Bt + (size_t)nxt.pb * tstep : cB;
#pragma clang loop unroll(disable)
        for (int t = 0; t < nt; t += 2) {
            const bool last = (t == nt - 2);
            if constexpr (GATHER) { if (last) { if (has_next) { PG8_GOFFS(voN, (ui + 1) & 1); } else {
#pragma unroll
                for (int _h = 0; _h < 2; ++_h)
#pragma unroll
                    for (int _i = 0; _i < 2; ++_i) voN[_h][_i] = voC[_h][_i]; } } }
            const char* a1 = cA + (size_t)(t + 1) * kstep;
            const char* a2 = last ? nA : cA + (size_t)(t + 2) * kstep; const char* b2 = last ? nB : cB + (size_t)(t + 2) * kstep;
            const char* a3 = a2 + kstep; const char* b3 = b2 + kstep;
            PG8_LDB(B0, 0, 0); PG8_LDB(B1, 0, 1); PG8_SCHED; PG8_LDA(At, 0, 0); PG8_STAGE_A(PG8_SA(1, 1), a1, 1, false);
            PG8_WAIT_V(8); PG8_WAIT_L(0); PG8_BAR; PG8_MMA(0, 0, At, B0); PG8_MMA(0, 1, At, B1); PG8_BAR; PG8_SCHED;
            PG8_LDA(At, 0, 1); PG8_STAGE(PG8_SB(0, 0), b2, voffB); PG8_STAGE(PG8_SB(0, 1), b2 + hstep, voffB); PG8_STAGE_A(PG8_SA(0, 0), a2, 0, last);
            PG8_WAIT_V(8); PG8_WAIT_L(0); PG8_BAR; PG8_MMA(1, 0, At, B0); PG8_MMA(1, 1, At, B1); PG8_BAR; PG8_SCHED;
            PG8_LDB(B0, 1, 0); PG8_LDB(B1, 1, 1); PG8_SCHED; PG8_LDA(At, 1, 0); PG8_STAGE_A(PG8_SA(0, 1), a2, 1, last);
            PG8_WAIT_V(8); PG8_WAIT_L(0); PG8_BAR; PG8_MMA(0, 0, At, B0); PG8_MMA(0, 1, At, B1); PG8_BAR; PG8_SCHED;
            PG8_LDA(At, 1, 1); PG8_STAGE(PG8_SB(1, 0), b3, voffB); PG8_STAGE(PG8_SB(1, 1), b3 + hstep, voffB); PG8_STAGE_A(PG8_SA(1, 0), a3, 0, last);
            PG8_WAIT_V(8); PG8_WAIT_L(0); PG8_BAR; PG8_MMA(1, 0, At, B0); PG8_MMA(1, 1, At, B1); PG8_BAR; PG8_SCHED;
            if constexpr (Epi::HAS_MID) { if (E.is_mid(t + 2)) E.mid(acc, cur, t + 2, wr, wc, fr, fq); }
        }
        if constexpr (ALIGN_EPI) { if (wr == 0) PG8_BAR; }
        if constexpr (F8) asm volatile("s_nop 15\n\ts_nop 15" ::: "memory");
        E(acc, cur, wr, wc, fr, fq);
        if (!has_next) break;
#pragma unroll
        for (int a = 0; a < 2; ++a)
#pragma unroll
            for (int b = 0; b < 2; ++b)
#pragma unroll
                for (int m = 0; m < 4; ++m)
#pragma unroll
                    for (int n = 0; n < 2; ++n) acc[a][b][m][n] = (f32x4){0.f, 0.f, 0.f, 0.f};
        cur = nxt; cA = nA; cB = nB; ++ui;
        if constexpr (GATHER) {
#pragma unroll
            for (int _h = 0; _h < 2; ++_h)
#pragma unroll
                for (int _i = 0; _i < 2; ++_i) voC[_h][_i] = voN[_h][_i]; }
        if constexpr (ALIGN_EPI) { if (wr == 1) PG8_BAR; }
    }
    PG8_WAIT_V(0);
    if constexpr (!ALIGN_EPI) { if (wr == 0) PG8_BAR; }
    PG8_BAR;
#undef PG8_GOFFS
#undef PG8_RMDMA
#undef PG8_STAGE_A
#undef PG8_SA
#undef PG8_SB
#undef PG8_STAGE
#undef PG8_LDA
#undef PG8_LDB
#undef PG8_MMA
#undef PG8_WAIT_V
#undef PG8_WAIT_L
#undef PG8_BAR
#undef PG8_SCHED
}
}
constexpr size_t MiB = 1u << 20;
constexpr size_t WS_CTL = 0, CTL_ZERO_BYTES = 1 * MiB;
constexpr size_t CTL_CMAX_IN = 98304;
constexpr size_t CTL_CMAX = 65536;
constexpr size_t WS_ROPE = 1 * MiB;
constexpr size_t WS_KMEAN = 2 * MiB;
constexpr size_t WS_ROUTE = 3 * MiB;
constexpr size_t RT_TOKE = 0, RT_TOKW = 128 * 1024, RT_SLOT = 256 * 1024, RT_ROWMAP = 384 * 1024, RT_META = 640 * 1024, RT_RTOK = 704 * 1024  , RT_RSLOT = 768 * 1024  ;
constexpr size_t WS_W = 4 * MiB;
constexpr size_t WL_IN = 0, WL_PA = 10752 * 1024, WL_PB = WL_PA + 512 * 1024, WL_PC = WL_PB + 1024 * 1024, WL_MIX = WL_PC + 512 * 1024,
                 WL_XQ = WL_MIX + 2 * MiB, WL_XKV = WL_XQ + 1 * MiB, WL_XO = WL_XKV + 2 * MiB, WL_SIZE = WL_XO + 1 * MiB;
static_assert(WL_SIZE == 18944 * 1024, "layer weight block");
constexpr size_t WS_FFN_GU = WS_W + 2 * WL_SIZE;
constexpr size_t WS_FFN_DN = WS_FFN_GU + 11 * MiB;
constexpr size_t WS_MOE_GU = 58 * MiB;
constexpr size_t WS_XN8 = 114 * MiB;
constexpr size_t WL_IN_G8 = 4608 * 1024;
constexpr size_t WS_MOE_DN = 170 * MiB;
constexpr size_t WS_MEMN = 226 * MiB;
constexpr size_t WS_KX = 230 * MiB;
constexpr size_t WS_VTX = 232 * MiB;
constexpr size_t WS_XN = 236 * MiB;
constexpr size_t WS_HEADS = 268 * MiB;
constexpr size_t HD_QA = 0, HD_KA = 8 * MiB, HD_VTA = 16 * MiB, HD_QB = 24 * MiB, HD_KB = 40 * MiB, HD_VTB = 44 * MiB, HD_QC = 48 * MiB, HD_KC = 56 * MiB, HD_VTC = 64 * MiB;
constexpr size_t WS_G = 340 * MiB;
constexpr size_t WS_QX = WS_G, WS_OX = WS_G + 16 * MiB;
constexpr size_t WS_O = 436 * MiB;
constexpr int O_A = 0, O_B = 256, O_C = 768;
constexpr size_t WS_UBF = WS_XN;
constexpr size_t WS_XRES = 468 * MiB;
constexpr int HFFN_LD = DFF + 64;
constexpr size_t WS_HFFN = WS_HEADS;
constexpr size_t WS_HMOE = WS_HEADS;
constexpr size_t WS_Y = 396 * MiB;
constexpr size_t WS_END = 500 * MiB;
static_assert( WS_HMOE + (size_t)73 * 256 * DFE * 2 <= WS_Y && WS_Y + (size_t)34816 * D * 2 <= WS_XRES && WS_HFFN + (size_t)M * HFFN_LD * 2 <= WS_OX + 16 * MiB && WS_FFN_DN + (size_t)D * HFFN_LD * 2 <= WS_MOE_GU, "ws map");
constexpr int MOE_MAX_RT = 136, MOE_CHUNK_RT = 64, MOE_X = 9;

constexpr int RING_BYTES = 131072, LDS_BYTES = 147456, MISC_OFF = LDS_BYTES - 256;
constexpr int NWAVES = 8;

#define XB_TMO      128
#define XB_XCNT(j)  (256  + 64 * (j))
#define XB_XSUB(j)  (1280 + 64 * (j))
#define XB_XGEN(j)  (2304 + 64 * (j))
#define XB_TOP      3328
#define XB_TOPGEN   3392
#define XCD_BAR_WORDS 3456
#define XB_SPIN_CAP (1u << 18)
__device__ __forceinline__ unsigned xb_ld(unsigned* p)              { return __hip_atomic_load(p, __ATOMIC_RELAXED, __HIP_MEMORY_SCOPE_AGENT); }
__device__ __forceinline__ unsigned xb_add(unsigned* p, unsigned v) { return __hip_atomic_fetch_add(p, v, __ATOMIC_RELAXED, __HIP_MEMORY_SCOPE_AGENT); }
__device__ __forceinline__ unsigned xb_xcc_id() { return (unsigned)__builtin_amdgcn_s_getreg((3 << 11) | 20) & 0xFu; }
#define XB_SPIN(cond, bar) do { unsigned _sp = 0; while (cond) { __builtin_amdgcn_s_sleep(1); \
    if ((++_sp & 255u) == 0u) { if (xb_ld(&(bar)[XB_TMO])) break; if (_sp > XB_SPIN_CAP) { atomicAdd(&(bar)[XB_TMO], 1u); break; } } } } while (0)
struct XcdBarrier { unsigned* bar; unsigned x; volatile LAS unsigned* st; };
__device__ __forceinline__ XcdBarrier xcd_barrier_post(unsigned* bar, volatile LAS unsigned* st, int tid) {
    XcdBarrier b; b.bar = bar; b.x = xb_xcc_id(); b.st = st;
    if (tid == 0) (void)xb_add(&bar[XB_XCNT(b.x)], 1u);
    return b;
}
__device__ __forceinline__ void xcd_barrier_complete(unsigned* bar, unsigned x, unsigned& nloc, unsigned& nx) {
    const unsigned G = gridDim.x * gridDim.y * gridDim.z;
    unsigned sum, cnt, mine, sp = 0u;
    for (;;) {
        sum = 0u; cnt = 0u; mine = 0u;
#pragma unroll
        for (unsigned j = 0; j < 16; ++j) { const unsigned c = xb_ld(&bar[XB_XCNT(j)]); sum += c; cnt += (c > 0u) ? 1u : 0u; mine = (j == x) ? c : mine; }
        if (sum == G) break;
        __builtin_amdgcn_s_sleep(1);
        if ((++sp & 255u) == 0u) { if (xb_ld(&bar[XB_TMO])) break; if (sp > XB_SPIN_CAP) { atomicAdd(&bar[XB_TMO], 1u); break; } }
    }
    nloc = mine > 0u ? mine : 1u; nx = cnt > 0u ? cnt : 1u;
}
__device__ __forceinline__ void xcd_barrier(const XcdBarrier& b, int tid  ) {
    asm volatile("s_waitcnt vmcnt(0)" ::: "memory");
    __syncthreads();
    if (tid == 0) {
        unsigned* bar = b.bar;
        __builtin_amdgcn_s_waitcnt(0);
        unsigned nloc = b.st[0], nx = b.st[1];
        if (nloc == 0u) { xcd_barrier_complete(bar, b.x, nloc, nx); b.st[0] = nloc; b.st[1] = nx; }
        const unsigned old = xb_add(&bar[XB_XSUB(b.x)], 1u);
        const unsigned gen = old / nloc;
        if (old + 1u == (gen + 1u) * nloc) {
            __builtin_amdgcn_fence(__ATOMIC_RELEASE, "agent");
            asm volatile("s_waitcnt vmcnt(0)" ::: "memory");
            const unsigned og = xb_add(&bar[XB_TOP], 1u);
            const unsigned tg = og / nx;
            if (og + 1u == (tg + 1u) * nx) xb_add(&bar[XB_TOPGEN], 1u);
            else XB_SPIN(xb_ld(&bar[XB_TOPGEN]) == tg, bar);
            __builtin_amdgcn_fence(__ATOMIC_ACQUIRE, "agent");
            xb_add(&bar[XB_XGEN(b.x)], 1u);
            asm volatile("s_waitcnt vmcnt(0)" ::: "memory");
        } else {
            XB_SPIN(xb_ld(&bar[XB_XGEN(b.x)]) == gen, bar);
            __builtin_amdgcn_fence(__ATOMIC_ACQUIRE, "agent");
            asm volatile("s_waitcnt vmcnt(0)" ::: "memory");
        }
    }
    __syncthreads();
}

using pg8::Unit;
__device__ __forceinline__ int pi32c(int r) { return (r & ~12) | ((r & 4) << 1) | ((r & 8) >> 1); }
template <bool I8> __device__ __forceinline__ f32x4 acc_val(const f32x4& a, const f32x4& cs, float rsv) {
    if constexpr (I8) return (f32x4){(float)__float_as_int(a[0]), (float)__float_as_int(a[1]), (float)__float_as_int(a[2]), (float)__float_as_int(a[3])} * (cs * rsv); else return a; }
template <bool I8> struct EpiInprojT {
    static constexpr bool PERM = true, HAS_MID = false;
    unsigned char* ws; const float* ropec; const float* ropes; LAS unsigned char* ldsx;
    const float* rs = nullptr; const unsigned* cmax = nullptr;
    __device__ __forceinline__ void operator()(const f32x4 (&acc)[2][2][4][2], const Unit& u, int wr, int wc, int fr, int fq) const {
        const int row0 = u.po * 256 + wr * 64 + fr;
        const int pn = u.pn;
        f32x4 cs[2][2];
#pragma unroll
        for (int bj = 0; bj < 2; ++bj)
#pragma unroll
            for (int n = 0; n < 2; ++n) { if constexpr (I8) { const u32x4 c4 = *(const u32x4*)(cmax + pn * 256 + bj * 128 + wc * 32 + 8 * fq + 4 * n);
                cs[bj][n] = (f32x4){__uint_as_float(c4.x), __uint_as_float(c4.y), __uint_as_float(c4.z), __uint_as_float(c4.w)} * (1.0f / 127.0f); } else cs[bj][n] = (f32x4){1.f, 1.f, 1.f, 1.f}; }
        float rsr[2][4];
#pragma unroll
        for (int ai = 0; ai < 2; ++ai)
#pragma unroll
            for (int m = 0; m < 4; ++m) rsr[ai][m] = I8 ? rs[row0 + ai * 128 + m * 16] : 1.f;
        if (pn >= 9) {
            bf16* G = (bf16*)(ws + WS_G);
            const int col0 = (pn - 9) * 256 + wc * 32 + 8 * fq;
            for (int rp = 0; rp < REPS(19); ++rp) { asm volatile("" ::: "memory");
#pragma unroll
            for (int ai = 0; ai < 2; ++ai)
#pragma unroll
                for (int m = 0; m < 4; ++m) { bf16* rowp = G + (size_t)(row0 + ai * 128 + m * 16) * 3072 + col0; const float rsv = rsr[ai][m];
#pragma unroll
                    for (int bj = 0; bj < 2; ++bj) { const f32x4 v0 = acc_val<I8>(acc[ai][bj][m][0], cs[bj][0], rsv), v1 = acc_val<I8>(acc[ai][bj][m][1], cs[bj][1], rsv); u32x4 w;
                        w.x = cvt_pk_bf16(sigmoidf_fast(v0[0]), sigmoidf_fast(v0[1])); w.y = cvt_pk_bf16(sigmoidf_fast(v0[2]), sigmoidf_fast(v0[3]));
                        w.z = cvt_pk_bf16(sigmoidf_fast(v1[0]), sigmoidf_fast(v1[1])); w.w = cvt_pk_bf16(sigmoidf_fast(v1[2]), sigmoidf_fast(v1[3]));
                        st16(rowp + bj * 128, w); } } }
            return;
        }
        int kind = 0  , H = 4, head = wc; bool rope = false; float sc = 1.f; size_t off = 0;
        switch (pn) {
            case 0: off = HD_QA; rope = true; sc = QSCALE64; break;
            case 1: off = HD_KA; rope = true; break;
            case 2: off = HD_VTA; kind = 1; break;
            case 3: off = HD_QB; H = 8; rope = true; sc = QSCALE64; break;
            case 4: off = HD_QB; H = 8; head = 4 + wc; rope = true; sc = QSCALE64; break;
            case 5: H = 2; if (wc < 2) { off = HD_KB; rope = true; } else { off = HD_VTB; kind = 1; head = wc - 2; } break;
            case 6: off = HD_QC; sc = QSCALE64; break;
            case 7: off = HD_KC; break;
            default: off = HD_VTC; kind = 1; break;
        }
        bf16* base = (bf16*)(ws + WS_HEADS + off);
        const int b = (u.po * 256) / T;
        const int tb = (u.po * 256) % T + wr * 64 + fr;
        if (kind == 0) { for (int rp = 0; rp < REPS(18); ++rp) { asm volatile("" ::: "memory");
            bf16* hb = base + ((size_t)(b * H + head) * T) * 64 + 8 * fq;
            const bool isk = (pn == 1) || (pn == 5) || (pn == 7);
            bf16* kbase = base + ((size_t)(b * H + head) * T) * 64;
            f32x4 rcb[1][4];
#define EI_LDROPE(buf, tt) do { rcb[buf][0] = *(const f32x4*)(ropec + (tt) * 32 + 8 * fq); rcb[buf][1] = *(const f32x4*)(ropec + (tt) * 32 + 8 * fq + 4); rcb[buf][2] = *(const f32x4*)(ropes + (tt) * 32 + 8 * fq); rcb[buf][3] = *(const f32x4*)(ropes + (tt) * 32 + 8 * fq + 4); } while (0)
            EI_LDROPE(0, tb);
#pragma unroll
            for (int it = 0; it < 8; ++it) { const int ai = it >> 2, m = it & 3; const int t = tb + ai * 128 + m * 16; const float rsv = rsr[ai][m];
                    f32x4 x1a = acc_val<I8>(acc[ai][0][m][0], cs[0][0], rsv), x1b = acc_val<I8>(acc[ai][0][m][1], cs[0][1], rsv), x2a = acc_val<I8>(acc[ai][1][m][0], cs[1][0], rsv), x2b = acc_val<I8>(acc[ai][1][m][1], cs[1][1], rsv);
                    if (rope) { const f32x4 ca = rcb[0][0], cb = rcb[0][1];
                        const f32x4 sa = rcb[0][2], sb = rcb[0][3];
                        const f32x4 y1a = x1a * ca - x2a * sa, y2a = x2a * ca + x1a * sa, y1b = x1b * cb - x2b * sb, y2b = x2b * cb + x1b * sb;
                        x1a = y1a; x2a = y2a; x1b = y1b; x2b = y2b; }
                    asm volatile("" ::: "memory");
                    if (it + 1 < 8) EI_LDROPE(0, tb + ((it + 1) >> 2) * 128 + ((it + 1) & 3) * 16);
                    x1a = x1a * sc; x1b = x1b * sc; x2a = x2a * sc; x2b = x2b * sc;
                    u32x4 w1, w2; w1.x = cvt_pk_bf16(x1a[0], x1a[1]); w1.y = cvt_pk_bf16(x1a[2], x1a[3]); w1.z = cvt_pk_bf16(x1b[0], x1b[1]); w1.w = cvt_pk_bf16(x1b[2], x1b[3]);
                    w2.x = cvt_pk_bf16(x2a[0], x2a[1]); w2.y = cvt_pk_bf16(x2a[2], x2a[3]); w2.z = cvt_pk_bf16(x2b[0], x2b[1]); w2.w = cvt_pk_bf16(x2b[2], x2b[3]);
                    if (isk) { bf16* kp = kbase + ((size_t)(t >> 5) * 8 + (fq & 1)) * 256 + (size_t)pi32c(t & 31) * 8 + (size_t)(fq >> 1) * 512;
                        st16(kp, w1); st16(kp + 1024, w2); }
                    else { bf16* rp = hb + (size_t)t * 64; st16(rp, w1); st16(rp + 32, w2); } }
#undef EI_LDROPE
        } } else { for (int rp = 0; rp < REPS(20); ++rp) { asm volatile("" ::: "memory");
            bf16* vb2 = base + (size_t)(b * H + head) * 64 * T;
            LAS bf16* tr = (LAS bf16*)(ldsx + (wr * 4 + wc) * 1024);
            const int ln = fq * 16 + fr, dd = ln >> 1, th = ln & 1;
#pragma unroll
            for (int ai = 0; ai < 2; ++ai)
#pragma unroll
                for (int m = 0; m < 4; ++m) { const int t16 = (u.po * 256) % T + wr * 64 + ai * 128 + m * 16;
                    const float rsv = rsr[ai][m];
#pragma unroll
                    for (int bj = 0; bj < 2; ++bj) {
#pragma unroll
                        for (int n = 0; n < 2; ++n) { const f32x4 av = acc_val<I8>(acc[ai][bj][m][n], cs[bj][n], rsv);
#pragma unroll
                            for (int e = 0; e < 4; e += 2) { const unsigned w = cvt_pk_bf16(av[e], av[e + 1]);
                                tr[(8 * fq + 4 * n + e) * 16 + fr] = (bf16)(w & 0xffffu); tr[(8 * fq + 4 * n + e + 1) * 16 + fr] = (bf16)(w >> 16); } }
                        const u32x4 v = *(const LAS u32x4*)(tr + dd * 16 + 8 * th);
                        const int t8 = t16 + 8 * th;
                        *(u32x4*)(vb2 + ((size_t)(((t8 >> 5) * 2 + bj) * 4 + ((t8 >> 3) & 3)) * 32 + dd) * 8) = v; } }
        } }
    }
};
using EpiInproj = EpiInprojT<false>;
struct EpiGates8 {
    static constexpr bool PERM = true, HAS_MID = false;
    unsigned char* ws;
    __device__ __forceinline__ void operator()(const f32x4 (&acc)[2][2][4][2], const Unit& u, int wr, int wc, int fr, int fq) const {
        bf16* G = (bf16*)(ws + WS_G);
        const int row0 = u.po * 256 + wr * 64 + fr, col0 = u.pn * 256 + wc * 32 + 8 * fq;
#pragma unroll
        for (int ai = 0; ai < 2; ++ai)
#pragma unroll
            for (int m = 0; m < 4; ++m) { bf16* rowp = G + (size_t)(row0 + ai * 128 + m * 16) * 3072 + col0;
#pragma unroll
                for (int bj = 0; bj < 2; ++bj) { const f32x4 v0 = acc[ai][bj][m][0] * F8_WINV, v1 = acc[ai][bj][m][1] * F8_WINV; u32x4 w;
                    w.x = cvt_pk_bf16(sigmoidf_fast(v0[0]), sigmoidf_fast(v0[1])); w.y = cvt_pk_bf16(sigmoidf_fast(v0[2]), sigmoidf_fast(v0[3]));
                    w.z = cvt_pk_bf16(sigmoidf_fast(v1[0]), sigmoidf_fast(v1[1])); w.w = cvt_pk_bf16(sigmoidf_fast(v1[2]), sigmoidf_fast(v1[3]));
                    st16(rowp + bj * 128, w); } }
    }
};
struct GateOrder {
    pg8::StaticOrder so; int nskip;
    __device__ void init(int G_, int c_, int nskip_) { so.init(M, 3072, G_, c_); nskip = nskip_; }
    __device__ __forceinline__ bool next(int i, Unit& u) const {
        long L; const int r = (so.c < nskip) ? i + 2 : i;
        if (r < 2) L = (long)r * (so.G - nskip) + (so.c - nskip); else L = 2L * (so.G - nskip) + (long)(r - 2) * so.G + so.c;
        int pm, pn; if (!so.next_L(L, pm, pn)) return false; u.pm = pm; u.pn = pn; u.pb = pn; u.po = pm; return true; }
};
struct EpiKvMem {
    static constexpr bool PERM = true, HAS_MID = false;
    unsigned char* ws;
    __device__ __forceinline__ void operator()(const f32x4 (&acc)[2][2][4][2], const Unit& u, int wr, int wc, int fr, int fq) const {
        const int lb = u.po;
        const int pn = u.pn & 3;
        const int j0 = wr * 64 + fr;
        if (pn < 2) {
            bf16* kx = (bf16*)(ws + WS_KX);
#pragma unroll
            for (int ai = 0; ai < 2; ++ai)
#pragma unroll
                for (int m = 0; m < 4; ++m) { const int j = j0 + ai * 128 + m * 16;
#pragma unroll
                    for (int bj = 0; bj < 2; ++bj) { const int head = 2 * pn + bj, d = wc * 32 + 8 * fq; const f32x4 v0 = acc[ai][bj][m][0], v1 = acc[ai][bj][m][1]; u32x4 w;
                        w.x = cvt_pk_bf16(v0[0], v0[1]); w.y = cvt_pk_bf16(v0[2], v0[3]); w.z = cvt_pk_bf16(v1[0], v1[1]); w.w = cvt_pk_bf16(v1[2], v1[3]);
                        *(u32x4*)(kx + (size_t)(lb * 4 + head) * 256 * 128 + ((size_t)((j >> 5) * 8 + (d >> 4)) * 2 + ((d >> 3) & 1)) * 256 + (size_t)pi32c(j & 31) * 8) = w; } }
        } else {
            bf16* vx = (bf16*)(ws + WS_VTX);
#pragma unroll
            for (int ai = 0; ai < 2; ++ai)
#pragma unroll
                for (int m = 0; m < 4; ++m) { const int j = j0 + ai * 128 + m * 16;
#pragma unroll
                    for (int bj = 0; bj < 2; ++bj) { const int head = 2 * (pn - 2) + bj;
#pragma unroll
                        for (int n = 0; n < 2; ++n)
#pragma unroll
                            for (int e = 0; e < 4; e += 2) { const int d = wc * 32 + 8 * fq + 4 * n + e; const unsigned w = cvt_pk_bf16(acc[ai][bj][m][n][e], acc[ai][bj][m][n][e + 1]);
                                bf16* p = vx + (size_t)(lb * 4 + head) * 128 * 256 + ((size_t)(((j >> 5) * 4 + (d >> 5)) * 4 + ((j >> 3) & 3)) * 32 + (d & 31)) * 8 + (j & 7); p[0] = (bf16)(w & 0xffffu); p[8] = (bf16)(w >> 16); } } }
        }
    }
};
struct EpiGateMix {
    static constexpr bool PERM = false, HAS_MID = true;
    const bf16* G; bf16* UBF;
    __device__ __forceinline__ bool is_mid(int t) const { return t == 4 || t == 12; }
    __device__ __forceinline__ void mid(f32x4 (&acc)[2][2][4][2], const Unit& u, int t, int wr, int wc, int fr, int fq) const {
        const int row0 = u.po * 256 + wr * 64 + fr, col0 = u.pn * 256 + wc * 32 + 4 * fq + (t == 4 ? 0 : 1024);
#pragma unroll
        for (int ai = 0; ai < 2; ++ai)
#pragma unroll
            for (int m = 0; m < 4; ++m) { const bf16* gr = G + (size_t)(row0 + ai * 128 + m * 16) * 3072 + col0;
#pragma unroll
                for (int bj = 0; bj < 2; ++bj)
#pragma unroll
                    for (int n = 0; n < 2; ++n) { const u32x2 gn = *(const u32x2*)(gr + bj * 128 + n * 16), gd = *(const u32x2*)(gr + bj * 128 + n * 16 + 1024);
                        f32x4 v = acc[ai][bj][m][n];
                        v[0] *= bflo(gn.x) * fast_rcp(fmaxf(bflo(gd.x), 1e-6f)); v[1] *= bfhi(gn.x) * fast_rcp(fmaxf(bfhi(gd.x), 1e-6f));
                        v[2] *= bflo(gn.y) * fast_rcp(fmaxf(bflo(gd.y), 1e-6f)); v[3] *= bfhi(gn.y) * fast_rcp(fmaxf(bfhi(gd.y), 1e-6f));
                        acc[ai][bj][m][n] = v; } }
    }
    __device__ __forceinline__ void operator()(const f32x4 (&acc)[2][2][4][2], const Unit& u, int wr, int wc, int fr, int fq) const {
        const int row0 = u.po * 256 + wr * 64 + fr, col0 = u.pn * 256 + wc * 32 + 4 * fq;
#pragma unroll
        for (int aim = 0; aim < 4; ++aim) { const int ai = aim >> 1;
            u32x2 gwb[4][2][2];
#pragma unroll
            for (int m = 2 * (aim & 1); m < 2 * (aim & 1) + 2; ++m)
#pragma unroll
                for (int bj = 0; bj < 2; ++bj)
#pragma unroll
                    for (int n = 0; n < 2; ++n) gwb[m][bj][n] = *(const u32x2*)(G + (size_t)(row0 + ai * 128 + m * 16) * 3072 + 2048 + col0 + bj * 128 + n * 16);
#pragma unroll
            for (int m = 2 * (aim & 1); m < 2 * (aim & 1) + 2; ++m) { const size_t r = (size_t)(row0 + ai * 128 + m * 16);
#pragma unroll
                for (int bj = 0; bj < 2; ++bj)
#pragma unroll
                    for (int n = 0; n < 2; ++n) { const int c = col0 + bj * 128 + n * 16; const u32x2 gw = gwb[m][bj][n];
                        const f32x4 v = acc[ai][bj][m][n]; u32x2 w;
                        w.x = cvt_pk_bf16(v[0] * fmaxf(bflo(gw.x), 1e-6f), v[1] * fmaxf(bfhi(gw.x), 1e-6f)); w.y = cvt_pk_bf16(v[2] * fmaxf(bflo(gw.y), 1e-6f), v[3] * fmaxf(bfhi(gw.y), 1e-6f));
                        st8(UBF + r * D + c, w); } } }
    }
};
template <bool FIRST> struct EpiResid {
    static constexpr bool PERM = true, HAS_MID = false;
    const float* x0; const bf16* XR; bf16* XO;
    __device__ __forceinline__ void operator()(const f32x4 (&acc)[2][2][4][2], const Unit& u, int wr, int wc, int fr, int fq) const {
        const int row0 = u.po * 256 + wr * 64 + fr, col0 = u.pn * 256 + wc * 32 + 8 * fq;
#pragma unroll
        for (int ai = 0; ai < 2; ++ai) {
            f32x4 pre[4][2][2];
#pragma unroll
            for (int m = 0; m < 4; ++m) { const size_t r = (size_t)(row0 + ai * 128 + m * 16) * D + col0;
#pragma unroll
                for (int bj = 0; bj < 2; ++bj) {
                    if (FIRST) { pre[m][bj][0] = *(const f32x4*)(x0 + r + bj * 128); pre[m][bj][1] = *(const f32x4*)(x0 + r + bj * 128 + 4); }
                    else { const u32x4 w = *(const u32x4*)(XR + r + bj * 128); pre[m][bj][0] = (f32x4){bflo(w.x), bfhi(w.x), bflo(w.y), bfhi(w.y)}; pre[m][bj][1] = (f32x4){bflo(w.z), bfhi(w.z), bflo(w.w), bfhi(w.w)}; } } }
#pragma unroll
            for (int m = 0; m < 4; ++m) { const size_t r = (size_t)(row0 + ai * 128 + m * 16) * D + col0;
#pragma unroll
                for (int bj = 0; bj < 2; ++bj) { const f32x4 v0 = pre[m][bj][0] + acc[ai][bj][m][0], v1 = pre[m][bj][1] + acc[ai][bj][m][1]; u32x4 w;
                    w.x = cvt_pk_bf16(v0[0], v0[1]); w.y = cvt_pk_bf16(v0[2], v0[3]); w.z = cvt_pk_bf16(v1[0], v1[1]); w.w = cvt_pk_bf16(v1[2], v1[3]);
                    st16(XO + r + bj * 128, w); } }
        }
    }
};
struct EpiXq {
    static constexpr bool PERM = true, HAS_MID = false;
    bf16* QX; float osc;
    __device__ __forceinline__ void operator()(const f32x4 (&acc)[2][2][4][2], const Unit& u, int wr, int wc, int fr, int fq) const {
        const int b = (u.po * 256) / T, tb = (u.po * 256) % T + wr * 64 + fr;
#pragma unroll
        for (int ai = 0; ai < 2; ++ai)
#pragma unroll
            for (int m = 0; m < 4; ++m) { const int t = tb + ai * 128 + m * 16; const float rn = osc;
#pragma unroll
                for (int bj = 0; bj < 2; ++bj) { const int head = 2 * u.pn + bj; const f32x4 v0 = acc[ai][bj][m][0] * rn, v1 = acc[ai][bj][m][1] * rn; u32x4 w;
                    w.x = cvt_pk_bf16(v0[0], v0[1]); w.y = cvt_pk_bf16(v0[2], v0[3]); w.z = cvt_pk_bf16(v1[0], v1[1]); w.w = cvt_pk_bf16(v1[2], v1[3]);
                    st16(QX + ((size_t)(b * 4 + head) * T + t) * 128 + wc * 32 + 8 * fq, w); } }
    }
};
struct EpiSwiglu {
    static constexpr bool PERM = true, HAS_MID = false;
    bf16* Hd; int ldh;
    __device__ __forceinline__ void operator()(const f32x4 (&acc)[2][2][4][2], const Unit& u, int wr, int wc, int fr, int fq) const {
        const int row0 = u.po * 256 + wr * 64 + fr, col0 = u.pn * 128 + wc * 32 + 8 * fq;
#pragma unroll
        for (int ai = 0; ai < 2; ++ai)
#pragma unroll
            for (int m = 0; m < 4; ++m) { float h[8];
#pragma unroll
                for (int n = 0; n < 2; ++n)
#pragma unroll
                    for (int e = 0; e < 4; ++e) { const float gt = acc[ai][0][m][n][e], up = acc[ai][1][m][n][e]; h[4 * n + e] = gt * sigmoidf_fast(gt) * up; }
                u32x4 w; w.x = cvt_pk_bf16(h[0], h[1]); w.y = cvt_pk_bf16(h[2], h[3]); w.z = cvt_pk_bf16(h[4], h[5]); w.w = cvt_pk_bf16(h[6], h[7]);
                st16(Hd + (size_t)(row0 + ai * 128 + m * 16) * ldh + col0, w); }
    }
};
struct EpiSwigluI8 {
    static constexpr bool PERM = true, HAS_MID = false;
    bf16* Hd; int ldh; const float* rs; const unsigned* cmax;
    __device__ __forceinline__ void operator()(const f32x4 (&acc)[2][2][4][2], const Unit& u, int wr, int wc, int fr, int fq) const {
        const int row0 = u.po * 256 + wr * 64 + fr, col0 = u.pn * 128 + wc * 32 + 8 * fq;
        float cg[8], cu[8];
        { const unsigned* cp = cmax + u.pn * 256 + wc * 32 + 8 * fq; const u32x4 g0 = *(const u32x4*)cp, g1 = *(const u32x4*)(cp + 4), u0 = *(const u32x4*)(cp + 128), u1 = *(const u32x4*)(cp + 132);
#pragma unroll
          for (int e = 0; e < 4; ++e) { cg[e] = __uint_as_float(g0[e]) * (1.0f / 127.0f); cg[4 + e] = __uint_as_float(g1[e]) * (1.0f / 127.0f); cu[e] = __uint_as_float(u0[e]) * (1.0f / 127.0f); cu[4 + e] = __uint_as_float(u1[e]) * (1.0f / 127.0f); } }
        float rsr[2][4];
#pragma unroll
        for (int ai = 0; ai < 2; ++ai)
#pragma unroll
            for (int m = 0; m < 4; ++m) rsr[ai][m] = rs[row0 + ai * 128 + m * 16];
#pragma unroll
        for (int ai = 0; ai < 2; ++ai)
#pragma unroll
            for (int m = 0; m < 4; ++m) { float h[8]; const float rsv = rsr[ai][m];
#pragma unroll
                for (int n = 0; n < 2; ++n)
#pragma unroll
                    for (int e = 0; e < 4; ++e) { const float gt = (float)__float_as_int(acc[ai][0][m][n][e]) * (rsv * cg[4 * n + e]), up = (float)__float_as_int(acc[ai][1][m][n][e]) * (rsv * cu[4 * n + e]); h[4 * n + e] = gt * sigmoidf_fast(gt) * up; }
                u32x4 w; w.x = cvt_pk_bf16(h[0], h[1]); w.y = cvt_pk_bf16(h[2], h[3]); w.z = cvt_pk_bf16(h[4], h[5]); w.w = cvt_pk_bf16(h[6], h[7]);
                st16(Hd + (size_t)(row0 + ai * 128 + m * 16) * ldh + col0, w); }
    }
};
struct EpiSwiglu8 {
    static constexpr bool PERM = true, HAS_MID = false;
    unsigned char* Hd; int ldh;
    __device__ __forceinline__ void operator()(const f32x4 (&acc)[2][2][4][2], const Unit& u, int wr, int wc, int fr, int fq) const {
        const int row0 = u.po * 256 + wr * 64 + fr, col0 = u.pn * 128 + wc * 32 + 8 * fq;
#pragma unroll
        for (int ai = 0; ai < 2; ++ai)
#pragma unroll
            for (int m = 0; m < 4; ++m) { float h[8];
#pragma unroll
                for (int n = 0; n < 2; ++n)
#pragma unroll
                    for (int e = 0; e < 4; ++e) { const float gt = acc[ai][0][m][n][e] * F8_WINV, up = acc[ai][1][m][n][e] * F8_WINV; h[4 * n + e] = gt * sigmoidf_fast(gt) * up; }
                u32x2 w; w.x = cvt_pk4_fp8(h[0], h[1], h[2], h[3]); w.y = cvt_pk4_fp8(h[4], h[5], h[6], h[7]);
                st8(Hd + (size_t)(row0 + ai * 128 + m * 16) * ldh + col0, w); }
    }
};
struct EpiBf16Out {
    static constexpr bool PERM = true, HAS_MID = false;
    bf16* O; int ldc; float sc;
    __device__ __forceinline__ void operator()(const f32x4 (&acc)[2][2][4][2], const Unit& u, int wr, int wc, int fr, int fq) const {
        const int row0 = u.po * 256 + wr * 64 + fr, col0 = u.pn * 256 + wc * 32 + 8 * fq;
#pragma unroll
        for (int ai = 0; ai < 2; ++ai)
#pragma unroll
            for (int m = 0; m < 4; ++m) { bf16* rowp = O + (size_t)(row0 + ai * 128 + m * 16) * ldc + col0;
#pragma unroll
                for (int bj = 0; bj < 2; ++bj) { const f32x4 v0 = acc[ai][bj][m][0] * sc, v1 = acc[ai][bj][m][1] * sc; u32x4 w;
                    w.x = cvt_pk_bf16(v0[0], v0[1]); w.y = cvt_pk_bf16(v0[2], v0[3]); w.z = cvt_pk_bf16(v1[0], v1[1]); w.w = cvt_pk_bf16(v1[2], v1[3]);
                    st16(rowp + bj * 128, w); } }
    }
};
struct Frame {
    LAS unsigned char* lds;
    int tid, lane, wave, G;
    unsigned char* ws;
};
__device__ __forceinline__ float wave_sum(float v) {
#pragma unroll
    for (int o = 1; o < 64; o <<= 1) v += __shfl_xor(v, o);
    return v;
}
#define LDS_WAIT() asm volatile("s_waitcnt lgkmcnt(0)" ::: "memory")
__device__ __forceinline__ Frame phase_frame(const Frame& F0) {
    Frame F = F0; int w = F0.wave; asm volatile("" : "+s"(w)); F.wave = w;
    int ln; asm volatile("v_mbcnt_lo_u32_b32 %0, -1, 0\n\tv_mbcnt_hi_u32_b32 %0, -1, %0" : "=&v"(ln));
    F.lane = ln; F.tid = w * 64 + ln;
    int g = F0.G; asm volatile("" : "+s"(g)); F.G = g; unsigned char* p = F0.ws; asm volatile("" : "+s"(p)); F.ws = p; return F; }

__device__ __forceinline__ float wave_max(float v) {
#pragma unroll
    for (int o = 1; o < 64; o <<= 1) v = fmaxf(v, __shfl_xor(v, o));
    return v;
}
__device__ __forceinline__ unsigned pack4_i8(float a, float b, float c, float d) { return ((unsigned)(int)rintf(a) & 255u) | (((unsigned)(int)rintf(b) & 255u) << 8) | (((unsigned)(int)rintf(c) & 255u) << 16) | ((unsigned)(int)rintf(d) << 24); }
template <int OUT8 = 0> __device__ __forceinline__ void transpose_item(const float* W, int ld, int col0, int k0, bf16* WT, int pitch, int row0, LAS float* scr, int lane, const unsigned* cmax = nullptr) {
    f32x4 wv[8];
#pragma unroll
    for (int i = 0; i < 8; ++i) wv[i] = *(const f32x4*)(W + (size_t)(k0 + 8 * i + (lane >> 3)) * ld + col0 + 4 * (lane & 7));
#pragma unroll
    for (int i = 0; i < 8; ++i) { LAS float* d = scr + (8 * i + (lane >> 3)) * 33 + 4 * (lane & 7); d[0] = wv[i][0]; d[1] = wv[i][1]; d[2] = wv[i][2]; d[3] = wv[i][3]; }
    LDS_WAIT(); asm volatile("" ::: "memory");
    const int c = lane & 7;
#pragma unroll
    for (int j = 0; j < 4; ++j) { const int n = (lane >> 3) + 8 * j; const LAS float* s = scr + (8 * c) * 33 + n;
        if constexpr (OUT8 == 2) { const float cm = __uint_as_float(cmax[row0 + n]), sc = cm > 0.f ? 127.0f / cm : 0.f;
            u32x2 o; o.x = pack4_i8(s[0 * 33] * sc, s[1 * 33] * sc, s[2 * 33] * sc, s[3 * 33] * sc); o.y = pack4_i8(s[4 * 33] * sc, s[5 * 33] * sc, s[6 * 33] * sc, s[7 * 33] * sc);
            st8((unsigned char*)WT + (size_t)(row0 + n) * pitch + k0 + 8 * c, o); continue; }
        if constexpr (OUT8 == 1) {
            u32x2 o; o.x = cvt_pk4_fp8(s[0 * 33] * F8_WSCALE, s[1 * 33] * F8_WSCALE, s[2 * 33] * F8_WSCALE, s[3 * 33] * F8_WSCALE); o.y = cvt_pk4_fp8(s[4 * 33] * F8_WSCALE, s[5 * 33] * F8_WSCALE, s[6 * 33] * F8_WSCALE, s[7 * 33] * F8_WSCALE);
            st8((unsigned char*)WT + (size_t)(row0 + n) * pitch + k0 + 8 * c, o); continue; }
        u32x4 o; o.x = cvt_pk_bf16(s[0 * 33], s[1 * 33]); o.y = cvt_pk_bf16(s[2 * 33], s[3 * 33]); o.z = cvt_pk_bf16(s[4 * 33], s[5 * 33]); o.w = cvt_pk_bf16(s[6 * 33], s[7 * 33]);
        st16(WT + (size_t)(row0 + n) * pitch + k0 + 8 * c, o); }
    LDS_WAIT(); asm volatile("" ::: "memory");
}
template <int MAP, int OUT8 = 0> __device__ __forceinline__ void transpose_matrix(const Frame& F, int& rot, const float* W, const float* W2, int ld, int K, int Nv, bf16* WT, LAS float* scr, int pitch = 0, const unsigned* cmax = nullptr) {
    if (pitch == 0) pitch = K;
    const int NGW = F.G * NWAVES; int gw = blockIdx.x * NWAVES + F.wave - rot; if (gw < 0) gw += NGW;
    const int ngrp = Nv / 32, nitems = (K / 64) * ngrp;
    rot = (rot + nitems) % NGW;
    for (int it = gw; it < nitems; it += NGW) {
        const int kb = it / ngrp, g = it % ngrp; const float* src = W; int col0 = 32 * g;
        if (MAP == 1) { if (g < 72) { const int tile = g >> 3, q = g & 7; col0 = 256 * tile + 64 * (q & 3) + 32 * (q >> 2); } }
        if (MAP == 2) { const int tile = g >> 3, q = g & 7; if (q < 4) { col0 = 128 * tile + 32 * q; } else { src = W2; col0 = 128 * tile + 32 * (q - 4); } }
        transpose_item<OUT8>(src, ld, col0, 64 * kb, WT, pitch, 32 * g, scr, F.lane, cmax);
    }
}
template <int MAP> __device__ __forceinline__ void f8_item(const float* W, const float* W2, int ld, int ngrp, int it, unsigned char* WT, int pitch, LAS float* scr, int lane) {
    const int kb = it / ngrp, g = it % ngrp; const float* src = W; int col0 = 32 * g;
    if (MAP == 2) { const int tile = g >> 3, q = g & 7; if (q < 4) { col0 = 128 * tile + 32 * q; } else { src = W2; col0 = 128 * tile + 32 * (q - 4); } }
    const int k0 = 128 * kb;
    f32x4 wv[16];
#pragma unroll
    for (int i = 0; i < 16; ++i) wv[i] = *(const f32x4*)(src + (size_t)(k0 + 8 * i + (lane >> 3)) * ld + col0 + 4 * (lane & 7));
#pragma unroll
    for (int i = 0; i < 16; ++i) { const int kk = 8 * i + (lane >> 3); LAS float* d = scr + kk * 33 + ((4 * (lane & 7) + 8 * (kk >> 4)) & 31); d[0] = wv[i][0]; d[1] = wv[i][1]; d[2] = wv[i][2]; d[3] = wv[i][3]; }
    LDS_WAIT(); asm volatile("" ::: "memory");
    const int c = lane & 7;
#pragma unroll
    for (int j = 0; j < 4; ++j) { const int n = (lane >> 3) + 8 * j; const LAS float* s = scr + (16 * c) * 33 + ((n + 8 * c) & 31);
        u32x4 o; o.x = cvt_pk4_fp8(s[0 * 33] * F8_WSCALE, s[1 * 33] * F8_WSCALE, s[2 * 33] * F8_WSCALE, s[3 * 33] * F8_WSCALE); o.y = cvt_pk4_fp8(s[4 * 33] * F8_WSCALE, s[5 * 33] * F8_WSCALE, s[6 * 33] * F8_WSCALE, s[7 * 33] * F8_WSCALE);
        o.z = cvt_pk4_fp8(s[8 * 33] * F8_WSCALE, s[9 * 33] * F8_WSCALE, s[10 * 33] * F8_WSCALE, s[11 * 33] * F8_WSCALE); o.w = cvt_pk4_fp8(s[12 * 33] * F8_WSCALE, s[13 * 33] * F8_WSCALE, s[14 * 33] * F8_WSCALE, s[15 * 33] * F8_WSCALE);
        st16(WT + (size_t)(32 * g + n) * pitch + k0 + 16 * c, o); }
    LDS_WAIT(); asm volatile("" ::: "memory");
}
constexpr int MOE_ITEMS_GU = (D / 128) * (2 * DFE / 32), MOE_ITEMS_DN = (DFE / 128) * (D / 32), MOE_ITEMS_E = MOE_ITEMS_GU + MOE_ITEMS_DN, MOE_ITEMS = NE * MOE_ITEMS_E;
#ifndef MOE_TAIL_A0
#define MOE_TAIL_A0 0
#define MOE_TAIL_A6 1
#define MOE_TAIL_A10 2
#endif
constexpr int MOE_TAIL_B6 = 160 * NWAVES * MOE_TAIL_A0, MOE_TAIL_B10 = MOE_TAIL_B6 + 128 * NWAVES * MOE_TAIL_A6, MOE_TAIL_ITEMS = MOE_TAIL_B10 + 128 * NWAVES * MOE_TAIL_A10;
static_assert(MOE_TAIL_ITEMS <= MOE_ITEMS, "tail shares");
__device__ __forceinline__ void moe_conv_item(int q, const float* mg, const float* mu, const float* md, unsigned char* ws, LAS float* scr, int lane) {
    const int e = q / MOE_ITEMS_E, r = q % MOE_ITEMS_E;
    if (r < MOE_ITEMS_GU) f8_item<2>(mg + (size_t)e * D * DFE, mu + (size_t)e * D * DFE, DFE, 2 * DFE / 32, r, ws + WS_MOE_GU + (size_t)e * 2 * DFE * D, D, scr, lane);
    else f8_item<0>(md + (size_t)e * DFE * D, nullptr, D, D / 32, r - MOE_ITEMS_GU, ws + WS_MOE_DN + (size_t)e * D * DFE, DFE, scr, lane);
}
__device__ __forceinline__ void moe_conv_tail(const Frame& F, int base, int rank, int n, const float* mg, const float* mu, const float* md) {
    LAS float* scr = (LAS float*)(F.lds + F.wave * 16896);
    for (int j = 0; j < n; ++j) moe_conv_item(base + (rank * NWAVES + F.wave) * n + j, mg, mu, md, F.ws, scr, F.lane);
}
template <int MAP> __device__ __forceinline__ void colmax_matrix(const Frame& F, int& rot, const float* W, const float* W2, int ld, int K, int Nv, unsigned* cmax) {
    const int NGW = F.G * NWAVES; int gw = blockIdx.x * NWAVES + F.wave - rot; if (gw < 0) gw += NGW;
    const int ngrp = Nv / 32, nitems = (K / 64) * ngrp;
    rot = (rot + nitems) % NGW;
    const int lane = F.lane;
    for (int it = gw; it < nitems; it += NGW) {
        const int kb = it / ngrp, g = it % ngrp; const float* src = W; int col0 = 32 * g;
        if (MAP == 1) { if (g < 72) { const int tile = g >> 3, q = g & 7; col0 = 256 * tile + 64 * (q & 3) + 32 * (q >> 2); } }
        if (MAP == 2) { const int tile = g >> 3, q = g & 7; if (q < 4) { col0 = 128 * tile + 32 * q; } else { src = W2; col0 = 128 * tile + 32 * (q - 4); } }
        f32x4 mx = {0.f, 0.f, 0.f, 0.f};
#pragma unroll
        for (int i = 0; i < 8; ++i) { const f32x4 w = *(const f32x4*)(src + (size_t)(64 * kb + 8 * i + (lane >> 3)) * ld + col0 + 4 * (lane & 7));
#pragma unroll
            for (int e = 0; e < 4; ++e) mx[e] = fmaxf(mx[e], fabsf(w[e])); }
#pragma unroll
        for (int e = 0; e < 4; ++e) { mx[e] = fmaxf(mx[e], __shfl_xor(mx[e], 8)); mx[e] = fmaxf(mx[e], __shfl_xor(mx[e], 16)); mx[e] = fmaxf(mx[e], __shfl_xor(mx[e], 32)); }
        if (lane < 8) {
#pragma unroll
            for (int e = 0; e < 4; ++e) atomicMax(cmax + 32 * g + 4 * lane + e, __float_as_uint(mx[e])); }
    }
}
template <bool ROUTER, bool SRCBF = true, bool WRITE = true, int OUT8 = 0  , bool ALSO8 = false> __device__ __forceinline__ void norm_rows(const Frame& F, const void* src, const float* gain, bf16* dst, int rows, const float* wrouter, int* tok_e, float* tok_w, float* rtok = nullptr, unsigned char* dst8 = nullptr, float* rscale = nullptr) {
    const int gw = blockIdx.x * NWAVES + F.wave, NGW = F.G * NWAVES;
    f32x4 gv[4];
#pragma unroll
    for (int j = 0; j < 4; ++j) gv[j] = *(const f32x4*)(gain + 4 * F.lane + 256 * j);
    constexpr int NRB = 4;
    for (int m0 = gw; m0 < rows; m0 += NRB * NGW) {
      u32x2 rawb[NRB][4]; f32x4 rawf[NRB][4];
#pragma unroll
      for (int i = 0; i < NRB; ++i) { const int mi = m0 + i * NGW, m = mi < rows ? mi : rows - 1;
#pragma unroll
          for (int j = 0; j < 4; ++j) { if (SRCBF) rawb[i][j] = ((const u32x2*)((const bf16*)src + (size_t)m * D) + F.lane)[64 * j]; else rawf[i][j] = ((const f32x4*)((const float*)src + (size_t)m * D) + F.lane)[64 * j]; } }
#pragma unroll
      for (int i = 0; i < NRB; ++i) { const int m = m0 + i * NGW; if (m >= rows) break;
        f32x4 v[4]; float s = 0.f;
#pragma unroll
        for (int j = 0; j < 4; ++j) {
            if (SRCBF) { const u32x2 w = rawb[i][j]; v[j] = (f32x4){bflo(w.x), bfhi(w.x), bflo(w.y), bfhi(w.y)}; }
            else v[j] = rawf[i][j];
            s += (v[j][0] * v[j][0] + v[j][1] * v[j][1]) + (v[j][2] * v[j][2] + v[j][3] * v[j][3]); }
        const float r = 1.0f / sqrtf(wave_sum(s) * (1.0f / D) + EPS);
        u32x2* o8 = (u32x2*)(dst + (size_t)m * D) + F.lane;
        if constexpr (OUT8 == 2) { float am = 0.f;
#pragma unroll
            for (int j = 0; j < 4; ++j) { v[j] = v[j] * r * gv[j]; am = fmaxf(fmaxf(am, fmaxf(fabsf(v[j][0]), fabsf(v[j][1]))), fmaxf(fabsf(v[j][2]), fabsf(v[j][3]))); }
            am = wave_max(am); const float inv = am > 0.f ? 127.0f / am : 0.f;
#pragma unroll
            for (int j = 0; j < 4; ++j) ((unsigned*)((unsigned char*)dst + (size_t)m * D) + F.lane)[64 * j] = pack4_i8(v[j][0] * inv, v[j][1] * inv, v[j][2] * inv, v[j][3] * inv);
            if (F.lane == 0) rscale[m] = am * (1.0f / 127.0f);
            continue; }
#pragma unroll
        for (int j = 0; j < 4; ++j) { v[j] = v[j] * r * gv[j]; if (ALSO8) ((unsigned*)(dst8 + (size_t)m * D) + F.lane)[64 * j] = cvt_pk4_fp8(v[j][0], v[j][1], v[j][2], v[j][3]);
            if (WRITE && OUT8 == 1) { ((unsigned*)((unsigned char*)dst + (size_t)m * D) + F.lane)[64 * j] = cvt_pk4_fp8(v[j][0], v[j][1], v[j][2], v[j][3]); } else if (WRITE) { u32x2 w; w.x = cvt_pk_bf16(v[j][0], v[j][1]); w.y = cvt_pk_bf16(v[j][2], v[j][3]); st8(o8 + 64 * j, w); } }
        if (ROUTER) {
            float lg[8];
#pragma unroll
            for (int e = 0; e < 8; ++e) lg[e] = 0.f;
#pragma unroll
            for (int j = 0; j < 4; ++j)
#pragma unroll
                for (int c = 0; c < 4; ++c) { const float* wp = wrouter + (size_t)(4 * F.lane + 256 * j + c) * 8; const f32x4 w0 = *(const f32x4*)wp, w1 = *(const f32x4*)(wp + 4); const float hv = v[j][c];
                    lg[0] = fmaf(hv, w0[0], lg[0]); lg[1] = fmaf(hv, w0[1], lg[1]); lg[2] = fmaf(hv, w0[2], lg[2]); lg[3] = fmaf(hv, w0[3], lg[3]);
                    lg[4] = fmaf(hv, w1[0], lg[4]); lg[5] = fmaf(hv, w1[1], lg[5]); lg[6] = fmaf(hv, w1[2], lg[6]); lg[7] = fmaf(hv, w1[3], lg[7]); }
#pragma unroll
            for (int e = 0; e < 8; ++e) lg[e] = wave_sum(lg[e]);
            if (F.lane == 0) {
                int i1 = 0; float v1 = lg[0];
#pragma unroll
                for (int e = 1; e < 8; ++e) if (lg[e] > v1) { v1 = lg[e]; i1 = e; }
                int i2 = 0; float v2 = -INFINITY;
#pragma unroll
                for (int e = 0; e < 8; ++e) if (e != i1 && lg[e] > v2) { v2 = lg[e]; i2 = e; }
                const float e2 = expf(v2 - v1); const float w1 = 1.0f / (1.0f + e2);
                tok_e[2 * m] = i1; tok_e[2 * m + 1] = i2; tok_w[2 * m] = w1; tok_w[2 * m + 1] = e2 * w1; if (rtok) rtok[m] = r;
            }
        }
      }
    }
}
__device__ __forceinline__ void moe_route(const Frame& F, const int* tok_e, int* tok_slot, int* rowmap, int* meta) {
    LAS int* cnt = (LAS int*)F.lds;
    LAS int* tot = cnt + 8 * 512;
    const int t0 = F.tid * 32;
    int c[8];
#pragma unroll
    for (int e = 0; e < 8; ++e) c[e] = 0;
    for (int i = 0; i < 64; ++i) { const int e = tok_e[2 * t0 + i];
#pragma unroll
        for (int k = 0; k < 8; ++k) c[k] += (e == k) ? 1 : 0; }
#pragma unroll
    for (int e = 0; e < 8; ++e) cnt[e * 512 + F.tid] = c[e];
    __syncthreads();
    {
        const int e = F.wave; int v[8]; int s = 0;
#pragma unroll
        for (int k = 0; k < 8; ++k) { v[k] = cnt[e * 512 + F.lane * 8 + k]; s += v[k]; }
        int incl = s;
#pragma unroll
        for (int o = 1; o < 64; o <<= 1) { const int y = __shfl_up(incl, o); if (F.lane >= o) incl += y; }
        int run = incl - s;
#pragma unroll
        for (int k = 0; k < 8; ++k) { cnt[e * 512 + F.lane * 8 + k] = run; run += v[k]; }
        if (F.lane == 63) tot[e] = incl;
    }
    __syncthreads();
    if (F.tid == 0) { int base = 0, rt = 0;
        for (int e = 0; e < 8; ++e) { const int n = tot[e], nt = (n + 255) >> 8; tot[8 + e] = base;
            for (int k = 0; k < nt; ++k) meta[16 + rt + k] = e;
            rt += nt; base += nt * 256; }
        meta[0] = rt; }
    __syncthreads();
    for (int e = 0; e < 8; ++e) { const int n = tot[e], base = tot[8 + e], end = base + (((n + 255) >> 8) << 8);
        for (int s = base + n + F.tid; s < end; s += 512) rowmap[s] = 0; }
    int run[8];
#pragma unroll
    for (int e = 0; e < 8; ++e) run[e] = tot[8 + e] + cnt[e * 512 + F.tid];
    for (int i = 0; i < 64; ++i) { const int e = tok_e[2 * t0 + i]; int slot = 0;
#pragma unroll
        for (int k = 0; k < 8; ++k) if (e == k) { slot = run[k]; run[k] += 1; }
        tok_slot[2 * t0 + i] = slot; rowmap[slot] = t0 + (i >> 1); }
    __syncthreads();
}
__device__ __forceinline__ void combine_final(const Frame& F, const bf16* x, const bf16* Y, const int* tok_slot, const float* tok_w, const float* gain, float* out) {
    const int gw = blockIdx.x * NWAVES + F.wave, NGW = F.G * NWAVES;
    f32x4 gv[4];
#pragma unroll
    for (int j = 0; j < 4; ++j) gv[j] = *(const f32x4*)(gain + 4 * F.lane + 256 * j);
    constexpr int NRB = 4;
    for (int m0 = gw; m0 < M; m0 += NRB * NGW) {
      int s1v[NRB], s2v[NRB]; float w1v[NRB], w2v[NRB];
#pragma unroll
      for (int i = 0; i < NRB; ++i) { const int mi = m0 + i * NGW, m = mi < M ? mi : M - 1; const u32x2 sl = *(const u32x2*)(tok_slot + 2 * m); const f32x2 tw = *(const f32x2*)(tok_w + 2 * m); s1v[i] = (int)sl.x; s2v[i] = (int)sl.y; w1v[i] = tw[0]; w2v[i] = tw[1]; }
      u32x2 rx[NRB][4], ra[NRB][4], rb[NRB][4];
#pragma unroll
      for (int i = 0; i < NRB; ++i) { const int mi = m0 + i * NGW, m = mi < M ? mi : M - 1;
        const u32x2* xr = (const u32x2*)(x + (size_t)m * D) + F.lane; const u32x2* y1 = (const u32x2*)(Y + (size_t)s1v[i] * D) + F.lane; const u32x2* y2 = (const u32x2*)(Y + (size_t)s2v[i] * D) + F.lane;
#pragma unroll
        for (int j = 0; j < 4; ++j) { rx[i][j] = xr[64 * j]; ra[i][j] = y1[64 * j]; rb[i][j] = y2[64 * j]; } }
#pragma unroll
      for (int i = 0; i < NRB; ++i) { const int m = m0 + i * NGW; if (m >= M) break; const float w1 = w1v[i], w2 = w2v[i];
        f32x4 v[4]; float s = 0.f;
#pragma unroll
        for (int j = 0; j < 4; ++j) { const u32x2 xw = rx[i][j]; v[j] = (f32x4){bflo(xw.x), bfhi(xw.x), bflo(xw.y), bfhi(xw.y)}; const u32x2 a = ra[i][j], b = rb[i][j];
            v[j][0] += w1 * bflo(a.x) + w2 * bflo(b.x); v[j][1] += w1 * bfhi(a.x) + w2 * bfhi(b.x); v[j][2] += w1 * bflo(a.y) + w2 * bflo(b.y); v[j][3] += w1 * bfhi(a.y) + w2 * bfhi(b.y);
            s += (v[j][0] * v[j][0] + v[j][1] * v[j][1]) + (v[j][2] * v[j][2] + v[j][3] * v[j][3]); }
        const float r = 1.0f / sqrtf(wave_sum(s) * (1.0f / D) + EPS);
        f32x4* o = (f32x4*)(out + (size_t)m * D) + F.lane;
#pragma unroll
        for (int j = 0; j < 4; ++j) o[64 * j] = v[j] * r * gv[j];
      }
    }
}

__device__ __forceinline__ int pi32(int r) { return (r & ~12) | ((r & 4) << 1) | ((r & 8) >> 1); }
#define MFMA32(a, b, c) __builtin_amdgcn_mfma_f32_32x32x16_bf16((a), (b), (c), 0, 0, 0)
template <int ND0> __device__ __forceinline__ f32x16 qk_tile(const bf16* Kh, int key0, const bf16x8* qr, int r32, int hi) {
    const bf16* kp = Kh + (size_t)(key0 >> 5) * (ND0 * 512) + (size_t)(hi * 32 + r32) * 8;
    f32x16 s = {0.f, 0.f, 0.f, 0.f, 0.f, 0.f, 0.f, 0.f, 0.f, 0.f, 0.f, 0.f, 0.f, 0.f, 0.f, 0.f};
#pragma unroll
    for (int d0 = 0; d0 < ND0; ++d0) { const bf16x8 kf = *(const GAS bf16x8*)(kp + d0 * 512); s = MFMA32(kf, qr[d0], s); }
    return s;
}
template <int NDT> __device__ __forceinline__ void pv_tile(const bf16* Vt, int, int key0, bf16x8 p0, bf16x8 p1, f32x16* o, int r32, int hi) {
    const bf16* vp = Vt + (size_t)(key0 >> 5) * (NDT * 1024) + (size_t)(hi * 32 + r32) * 8;
#pragma unroll
    for (int dt = 0; dt < NDT; ++dt) { const bf16x8 v0 = *(const GAS bf16x8*)(vp + dt * 1024), v1 = *(const GAS bf16x8*)(vp + dt * 1024 + 512);
        o[dt] = MFMA32(v0, p0, o[dt]); o[dt] = MFMA32(v1, p1, o[dt]); }
}
__device__ __forceinline__ bf16x8 pack8(const f32x16& p, int b) {
    u32x4 w; w.x = cvt_pk_bf16(p[b], p[b + 1]); w.y = cvt_pk_bf16(p[b + 2], p[b + 3]); w.z = cvt_pk_bf16(p[b + 4], p[b + 5]); w.w = cvt_pk_bf16(p[b + 6], p[b + 7]);
    return __builtin_bit_cast(bf16x8, w);
}
__device__ __forceinline__ float xhalf_max(float v) { auto rr = __builtin_amdgcn_permlane32_swap(__float_as_uint(v), __float_as_uint(v), false, false); return fmaxf(__uint_as_float(rr[0]), __uint_as_float(rr[1])); }
__device__ __forceinline__ float xhalf_sum(float v) { auto rr = __builtin_amdgcn_permlane32_swap(__float_as_uint(v), __float_as_uint(v), false, false); return __uint_as_float(rr[0]) + __uint_as_float(rr[1]); }
template <int NDT> __device__ __forceinline__ void softmax_step(f32x16& s, float& m, float& l, f32x16* o, bf16x8& p0, bf16x8& p1) {
    float tm = fmaxf(fmaxf(s[0], s[1]), fmaxf(s[2], s[3]));
#pragma unroll
    for (int r = 4; r < 16; r += 4) tm = fmaxf(tm, fmaxf(fmaxf(s[r], s[r + 1]), fmaxf(s[r + 2], s[r + 3])));
    tm = xhalf_max(tm);
    const float mn = fmaxf(m, tm), al = fast_exp2(m - mn); m = mn;
    float ps = 0.f;
#pragma unroll
    for (int r = 0; r < 16; ++r) { s[r] = fast_exp2(s[r] - mn); ps += s[r]; }
    l = l * al + ps;
#pragma unroll
    for (int dt = 0; dt < NDT; ++dt)
#pragma unroll
        for (int r = 0; r < 16; ++r) o[dt][r] *= al;
    p0 = pack8(s, 0); p1 = pack8(s, 8);
}
template <int NDT> __device__ __forceinline__ void store_o(bf16* Orow  , const f32x16* o, float scale, int hi) {
#pragma unroll
    for (int dt = 0; dt < NDT; ++dt)
#pragma unroll
        for (int g = 0; g < 4; ++g) { u32x2 w; w.x = cvt_pk_bf16(o[dt][4 * g] * scale, o[dt][4 * g + 1] * scale); w.y = cvt_pk_bf16(o[dt][4 * g + 2] * scale, o[dt][4 * g + 3] * scale);
            st8(Orow + dt * 32 + 8 * g + 4 * hi, w); }
}
template <int ND0> __device__ __forceinline__ void load_q(bf16x8* qr, const bf16* Qh  , int t0, int r32, int hi) {
#pragma unroll
    for (int d0 = 0; d0 < ND0; ++d0) qr[d0] = *(const GAS bf16x8*)(Qh + (size_t)(t0 + r32) * (16 * ND0) + d0 * 16 + hi * 8);
}
#define KEY_OF(r, hi) (16 * ((r) >> 3) + 8 * (hi) + ((r) & 7))

template <int ND0> __device__ __forceinline__ void load_k(bf16x8* kf, const bf16* Kh, int key0, int r32, int hi) {
    const bf16* kp = Kh + (size_t)(key0 >> 5) * (ND0 * 512) + (size_t)(hi * 32 + r32) * 8;
#pragma unroll
    for (int d0 = 0; d0 < ND0; ++d0) kf[d0] = *(const GAS bf16x8*)(kp + d0 * 512);
}
template <int NDT> __device__ __forceinline__ void load_v(bf16x8* vf, const bf16* Vt, int  , int key0, int r32, int hi) {
    const bf16* vp = Vt + (size_t)(key0 >> 5) * (NDT * 1024) + (size_t)(hi * 32 + r32) * 8;
#pragma unroll
    for (int dt = 0; dt < NDT; ++dt) { vf[2 * dt] = *(const GAS bf16x8*)(vp + dt * 1024); vf[2 * dt + 1] = *(const GAS bf16x8*)(vp + dt * 1024 + 512); }
}
template <int MK> __device__ __forceinline__ void apply_mask(f32x16& s, int r32, int hi) {
    if (MK == 1) {
#pragma unroll
        for (int r = 0; r < 16; ++r) if (KEY_OF(r, hi) > r32) s[r] = -INFINITY; }
    if (MK == 2) {
#pragma unroll
        for (int r = 0; r < 16; ++r) if (KEY_OF(r, hi) <= r32) s[r] = -INFINITY; }
}
__device__ __forceinline__ float max16(const f32x16& s) {
    float a = fmaxf(fmaxf(s[0], s[1]), fmaxf(s[2], s[3]));
#pragma unroll
    for (int r = 4; r < 16; r += 4) a = fmaxf(a, fmaxf(fmaxf(s[r], s[r + 1]), fmaxf(s[r + 2], s[r + 3])));
    return a;
}
template <int ND0, int NDT, bool HAS2, int MA, int MB>
__device__ __forceinline__ void flash_compute(const bf16x8* kfa, const bf16x8* kfb, const bf16x8* va, const bf16x8* vb, const bf16x8* qr, float lane_inf, float& m, float& l, f32x16* o, int r32, int hi);
template <int ND0, int NDT, bool HAS2, int MA, int MB>
__device__ __forceinline__ void flash_step(const bf16x8* kfa, const bf16x8* kfb, const bf16* Vt, int ldv, int key0a, int key0b, const bf16x8* qr, float lane_inf,
                                           float& m, float& l, f32x16* o, int r32, int hi) {
    bf16x8 va[2 * NDT], vb[2 * NDT];
    load_v<NDT>(va, Vt, ldv, key0a, r32, hi);
    if (HAS2) load_v<NDT>(vb, Vt, ldv, key0b, r32, hi);
    flash_compute<ND0, NDT, HAS2, MA, MB>(kfa, kfb, va, vb, qr, lane_inf, m, l, o, r32, hi);
}
template <int ND0, int NDT, bool HAS2, int MA, int MB>
__device__ __forceinline__ void flash_compute(const bf16x8* kfa, const bf16x8* kfb, const bf16x8* va, const bf16x8* vb, const bf16x8* qr, float lane_inf, float& m, float& l, f32x16* o, int r32, int hi) {
    f32x16 sa = {0.f, 0.f, 0.f, 0.f, 0.f, 0.f, 0.f, 0.f, 0.f, 0.f, 0.f, 0.f, 0.f, 0.f, 0.f, 0.f}, sb = sa;
#pragma unroll
    for (int d0 = 0; d0 < ND0; ++d0) { sa = MFMA32(kfa[d0], qr[d0], sa); if (HAS2) sb = MFMA32(kfb[d0], qr[d0], sb); }
    apply_mask<MA>(sa, r32, hi); if (HAS2) apply_mask<MB>(sb, r32, hi);
    float tm = max16(sa); if (HAS2) tm = fmaxf(tm, max16(sb));
    tm = xhalf_max(tm) - lane_inf;
    if (__builtin_amdgcn_ballot_w64(tm > m) != 0ull) {
        const float mn = fmaxf(m, tm), al = fast_exp2(m - mn); m = mn; l *= al;
#pragma unroll
        for (int dt = 0; dt < NDT; ++dt)
#pragma unroll
            for (int r = 0; r < 16; ++r) o[dt][r] *= al;
    }
    const float ms = m + lane_inf;
    float ps = 0.f;
#pragma unroll
    for (int r = 0; r < 16; ++r) { sa[r] = fast_exp2(sa[r] - ms); ps += sa[r]; }
    if (HAS2) {
#pragma unroll
        for (int r = 0; r < 16; ++r) { sb[r] = fast_exp2(sb[r] - ms); ps += sb[r]; } }
    l += ps;
    const bf16x8 pa0 = pack8(sa, 0), pa1 = pack8(sa, 8);
#pragma unroll
    for (int dt = 0; dt < NDT; ++dt) { o[dt] = MFMA32(va[2 * dt], pa0, o[dt]); o[dt] = MFMA32(va[2 * dt + 1], pa1, o[dt]); }
    if (HAS2) { const bf16x8 pb0 = pack8(sb, 0), pb1 = pack8(sb, 8);
#pragma unroll
        for (int dt = 0; dt < NDT; ++dt) { o[dt] = MFMA32(vb[2 * dt], pb0, o[dt]); o[dt] = MFMA32(vb[2 * dt + 1], pb1, o[dt]); } }
}
#define COPY_K(dst, src, N) do { _Pragma("unroll") for (int _d = 0; _d < (N); ++_d) dst[_d] = src[_d]; } while (0)

__device__ __forceinline__ void moba_item(const Frame& F, int b, int h, int qt, const float* kmean) {
    const int lane = F.lane, r32 = lane & 31, hi = lane >> 5, r32p = pi32(r32);
    const bf16* Qh = (const bf16*)(F.ws + WS_HEADS + HD_QA) + (size_t)(b * 4 + h) * T * 64;
    const bf16* Kh = (const bf16*)(F.ws + WS_HEADS + HD_KA) + (size_t)(b * 4 + h) * T * 64;
    const bf16* Vt = (const bf16*)(F.ws + WS_HEADS + HD_VTA) + (size_t)(b * 4 + h) * 64 * T;
    const int t0 = qt * 32, own = t0 >> 8;
    bf16x8 qr[4]; load_q<4>(qr, Qh, t0, r32, hi);
    bf16x8 kfa[4], kfb[4], kna[4], knb[4];
    const int NT = qt + 1;
    load_k<4>(kfa, Kh, 0, r32, hi); if (NT > 1) load_k<4>(kfb, Kh, 32, r32, hi);
    unsigned selmask = 0u;
    if (own > 0) {
        float sc[16];
        const float* km = kmean + (size_t)(b * 4 + h) * 16 * 64 + hi * 8;
        float qf[32];
#pragma unroll
        for (int d0 = 0; d0 < 4; ++d0) { const u32x4 w = __builtin_bit_cast(u32x4, qr[d0]); qf[8 * d0 + 0] = bflo(w.x); qf[8 * d0 + 1] = bfhi(w.x); qf[8 * d0 + 2] = bflo(w.y); qf[8 * d0 + 3] = bfhi(w.y);
            qf[8 * d0 + 4] = bflo(w.z); qf[8 * d0 + 5] = bfhi(w.z); qf[8 * d0 + 6] = bflo(w.w); qf[8 * d0 + 7] = bfhi(w.w); }
#pragma unroll
        for (int j = 0; j < 15; ++j) { float a = 0.f;
            if (j < own) {
#pragma unroll
                for (int d0 = 0; d0 < 4; ++d0) { const f32x4 k0 = *(const f32x4*)(km + j * 64 + d0 * 16), k1 = *(const f32x4*)(km + j * 64 + d0 * 16 + 4);
                    a = fmaf(qf[8 * d0 + 0], k0[0], a); a = fmaf(qf[8 * d0 + 1], k0[1], a); a = fmaf(qf[8 * d0 + 2], k0[2], a); a = fmaf(qf[8 * d0 + 3], k0[3], a);
                    a = fmaf(qf[8 * d0 + 4], k1[0], a); a = fmaf(qf[8 * d0 + 5], k1[1], a); a = fmaf(qf[8 * d0 + 6], k1[2], a); a = fmaf(qf[8 * d0 + 7], k1[3], a); }
                a = xhalf_sum(a);
            } else a = -INFINITY;
            sc[j] = a; }
        sc[15] = -INFINITY;
        const int nsel = own < 3 ? own : 3;
#pragma unroll
        for (int r = 0; r < 3; ++r) if (r < nsel) { int bi = 0; float bv = -INFINITY;
#pragma unroll
            for (int j = 0; j < 15; ++j) if (sc[j] > bv) { bv = sc[j]; bi = j; }
            selmask |= 1u << bi;
#pragma unroll
            for (int j = 0; j < 15; ++j) if (j == bi) sc[j] = -INFINITY; }
    }
    selmask |= 1u << own;
    float m = -1e30f, l = 0.f; f32x16 o[2];
#pragma unroll
    for (int dt = 0; dt < 2; ++dt)
#pragma unroll
        for (int r = 0; r < 16; ++r) o[dt][r] = 0.f;
    const int nfull = (NT - 1) >> 1;
    for (int s = 0; s < nfull; ++s) {
        const int key0 = 64 * s;
        if (2 * s + 2 < NT) load_k<4>(kna, Kh, key0 + 64, r32, hi);
        if (2 * s + 3 < NT) load_k<4>(knb, Kh, key0 + 96, r32, hi);
        const float lane_inf = ((selmask >> (s >> 2)) & 1u) ? 0.f : INFINITY;
        flash_step<4, 2, true, 0, 0>(kfa, kfb, Vt, T, key0, key0 + 32, qr, lane_inf, m, l, o, r32, hi);
        COPY_K(kfa, kna, 4); COPY_K(kfb, knb, 4);
    }
    if (NT & 1) flash_step<4, 2, false, 1, 0>(kfa, kfb, Vt, T, 64 * nfull, 0, qr, 0.f, m, l, o, r32, hi);
    else        flash_step<4, 2, true, 0, 1>(kfa, kfb, Vt, T, 64 * nfull, 64 * nfull + 32, qr, 0.f, m, l, o, r32, hi);
    l = xhalf_sum(l);
    bf16* Orow = (bf16*)(F.ws + WS_O) + (size_t)(b * T + t0 + r32) * D + O_A + h * 64;
    store_o<2>(Orow, o, fast_rcp(l), hi);
}
__device__ __forceinline__ void moba_wg(const Frame& F, int b, int h, int qt, int S_total, const float* kmean) {
    const int lane = F.lane, r32 = lane & 31, hi = lane >> 5;
    const bf16* Qh = (const bf16*)(F.ws + WS_HEADS + HD_QA) + (size_t)(b * 4 + h) * T * 64;
    const unsigned char* Kg = F.ws + WS_HEADS + HD_KA + (size_t)(b * 4 + h) * T * 64 * 2;
    const unsigned char* Vg = F.ws + WS_HEADS + HD_VTA + (size_t)(b * 4 + h) * 64 * T * 2;
    LAS unsigned char* ring = F.lds;
#define MW_ISSUE(s) do { const int _sc = (s) < S_total ? (s) : S_total - 1; \
        __builtin_amdgcn_global_load_lds((const unsigned*)(Kg + (size_t)_sc * 8192 + F.wave * 1024 + lane * 16), (LAS unsigned*)(ring + ((s) & 3) * 16384 + F.wave * 1024), 16, 0, 0); \
        __builtin_amdgcn_global_load_lds((const unsigned*)(Vg + (size_t)_sc * 8192 + F.wave * 1024 + lane * 16), (LAS unsigned*)(ring + ((s) & 3) * 16384 + 8192 + F.wave * 1024), 16, 0, 0); } while (0)
    const int t0 = qt * 32, own = t0 >> 8;
    bf16x8 qr[4]; load_q<4>(qr, Qh, t0, r32, hi);
    const int NT = qt + 1;
    unsigned selmask = 0u;
    if (own > 0) {
        float sc[16];
        const float* km = kmean + (size_t)(b * 4 + h) * 16 * 64 + hi * 8;
        float qf[32];
#pragma unroll
        for (int d0 = 0; d0 < 4; ++d0) { const u32x4 w = __builtin_bit_cast(u32x4, qr[d0]); qf[8 * d0 + 0] = bflo(w.x); qf[8 * d0 + 1] = bfhi(w.x); qf[8 * d0 + 2] = bflo(w.y); qf[8 * d0 + 3] = bfhi(w.y);
            qf[8 * d0 + 4] = bflo(w.z); qf[8 * d0 + 5] = bfhi(w.z); qf[8 * d0 + 6] = bflo(w.w); qf[8 * d0 + 7] = bfhi(w.w); }
#pragma unroll
        for (int j = 0; j < 15; ++j) { float a = 0.f;
            if (j < own) {
#pragma unroll
                for (int d0 = 0; d0 < 4; ++d0) { const f32x4 k0 = *(const f32x4*)(km + j * 64 + d0 * 16), k1 = *(const f32x4*)(km + j * 64 + d0 * 16 + 4);
                    a = fmaf(qf[8 * d0 + 0], k0[0], a); a = fmaf(qf[8 * d0 + 1], k0[1], a); a = fmaf(qf[8 * d0 + 2], k0[2], a); a = fmaf(qf[8 * d0 + 3], k0[3], a);
                    a = fmaf(qf[8 * d0 + 4], k1[0], a); a = fmaf(qf[8 * d0 + 5], k1[1], a); a = fmaf(qf[8 * d0 + 6], k1[2], a); a = fmaf(qf[8 * d0 + 7], k1[3], a); }
                a = xhalf_sum(a);
            } else a = -INFINITY;
            sc[j] = a; }
        sc[15] = -INFINITY;
        const int nsel = own < 3 ? own : 3;
#pragma unroll
        for (int r = 0; r < 3; ++r) if (r < nsel) { int bi = 0; float bv = -INFINITY;
#pragma unroll
            for (int j = 0; j < 15; ++j) if (sc[j] > bv) { bv = sc[j]; bi = j; }
            selmask |= 1u << bi;
#pragma unroll
            for (int j = 0; j < 15; ++j) if (j == bi) sc[j] = -INFINITY; }
    }
    selmask |= 1u << own;
    asm volatile("s_waitcnt vmcnt(0)" ::: "memory");
    MW_ISSUE(0); MW_ISSUE(1); MW_ISSUE(2);
    float m = -1e30f, l = 0.f; f32x16 o[2];
#pragma unroll
    for (int dt = 0; dt < 2; ++dt)
#pragma unroll
        for (int r = 0; r < 16; ++r) o[dt][r] = 0.f;
    const int nfull = (NT - 1) >> 1;
    for (int s = 0; s < S_total; ++s) {
        asm volatile("s_waitcnt vmcnt(4)" ::: "memory");
        __builtin_amdgcn_s_barrier();
        MW_ISSUE(s + 3);
        if (s <= nfull) {
            const LAS bf16* Kl = (const LAS bf16*)(ring + (s & 3) * 16384) + lane * 8; const LAS bf16* Vl = Kl + 4096;
            bf16x8 ka[4], kb[4], va[4], vb[4];
#pragma unroll
            for (int d0 = 0; d0 < 4; ++d0) { ka[d0] = *(const LAS bf16x8*)(Kl + d0 * 512); kb[d0] = *(const LAS bf16x8*)(Kl + 2048 + d0 * 512); }
#pragma unroll
            for (int dt = 0; dt < 2; ++dt) { va[2 * dt] = *(const LAS bf16x8*)(Vl + dt * 1024); va[2 * dt + 1] = *(const LAS bf16x8*)(Vl + dt * 1024 + 512);
                vb[2 * dt] = *(const LAS bf16x8*)(Vl + 2048 + dt * 1024); vb[2 * dt + 1] = *(const LAS bf16x8*)(Vl + 2048 + dt * 1024 + 512); }
            if (s < nfull) { const float lane_inf = ((selmask >> (s >> 2)) & 1u) ? 0.f : INFINITY; flash_compute<4, 2, true, 0, 0>(ka, kb, va, vb, qr, lane_inf, m, l, o, r32, hi); }
            else if (NT & 1) flash_compute<4, 2, false, 1, 0>(ka, kb, va, vb, qr, 0.f, m, l, o, r32, hi);
            else flash_compute<4, 2, true, 0, 1>(ka, kb, va, vb, qr, 0.f, m, l, o, r32, hi);
        }
    }
#undef MW_ISSUE
    l = xhalf_sum(l);
    bf16* Orow = (bf16*)(F.ws + WS_O) + (size_t)(b * T + t0 + r32) * D + O_A + h * 64;
    store_o<2>(Orow, o, fast_rcp(l), hi);
    asm volatile("s_waitcnt vmcnt(0)" ::: "memory");
    __syncthreads();
}
__device__ __forceinline__ void swa_item(const Frame& F, int b, int hq, int qt, const float* sinks) {
    const int lane = F.lane, r32 = lane & 31, hi = lane >> 5, r32p = pi32(r32); const int kvh = hq >> 2;
    const bf16* Qh = (const bf16*)(F.ws + WS_HEADS + HD_QB) + (size_t)(b * 8 + hq) * T * 64;
    const bf16* Kh = (const bf16*)(F.ws + WS_HEADS + HD_KB) + (size_t)(b * 2 + kvh) * T * 64;
    const bf16* Vt = (const bf16*)(F.ws + WS_HEADS + HD_VTB) + (size_t)(b * 2 + kvh) * 64 * T;
    const int t0 = qt * 32;
    bf16x8 qr[4]; load_q<4>(qr, Qh, t0, r32, hi);
    float m = -1e30f, l = 0.f; f32x16 o[2];
#pragma unroll
    for (int dt = 0; dt < 2; ++dt)
#pragma unroll
        for (int r = 0; r < 16; ++r) o[dt][r] = 0.f;
    bf16x8 k0[4], k1[4], k2[4], k3[4], k4[4];
    if (t0 >= 128) {
        load_k<4>(k0, Kh, t0 - 128, r32, hi); load_k<4>(k1, Kh, t0 - 96, r32, hi); load_k<4>(k2, Kh, t0 - 64, r32, hi); load_k<4>(k3, Kh, t0 - 32, r32, hi); load_k<4>(k4, Kh, t0, r32, hi);
        flash_step<4, 2, true, 2, 0>(k0, k1, Vt, T, t0 - 128, t0 - 96, qr, 0.f, m, l, o, r32, hi);
        flash_step<4, 2, true, 0, 0>(k2, k3, Vt, T, t0 - 64, t0 - 32, qr, 0.f, m, l, o, r32, hi);
        flash_step<4, 2, false, 1, 0>(k4, k4, Vt, T, t0, 0, qr, 0.f, m, l, o, r32, hi);
    } else {
        for (int key0 = 0; key0 < t0; key0 += 32) { load_k<4>(k0, Kh, key0, r32, hi); flash_step<4, 2, false, 0, 0>(k0, k0, Vt, T, key0, 0, qr, 0.f, m, l, o, r32, hi); }
        load_k<4>(k4, Kh, t0, r32, hi); flash_step<4, 2, false, 1, 0>(k4, k4, Vt, T, t0, 0, qr, 0.f, m, l, o, r32, hi);
    }
    l = xhalf_sum(l) + fast_exp2(sinks[hq] * LOG2E - m);
    bf16* Orow = (bf16*)(F.ws + WS_O) + (size_t)(b * T + t0 + r32) * D + O_B + hq * 64;
    store_o<2>(Orow, o, fast_rcp(l), hi);
}
__device__ __forceinline__ void sb_item(const Frame& F, int b, int h, int qt) {
    const int lane = F.lane, r32 = lane & 31, hi = lane >> 5, r32p = pi32(r32);
    const bf16* Qh = (const bf16*)(F.ws + WS_HEADS + HD_QC) + (size_t)(b * 4 + h) * T * 64;
    const bf16* Kh = (const bf16*)(F.ws + WS_HEADS + HD_KC) + (size_t)(b * 4 + h) * T * 64;
    const bf16* Vt = (const bf16*)(F.ws + WS_HEADS + HD_VTC) + (size_t)(b * 4 + h) * 64 * T;
    const int t0 = qt * 32;
    bf16x8 qr[4]; load_q<4>(qr, Qh, t0, r32, hi);
    f32x16 o[2];
#pragma unroll
    for (int dt = 0; dt < 2; ++dt)
#pragma unroll
        for (int r = 0; r < 16; ++r) o[dt][r] = 0.f;
    float carry = 1.0f;
    for (int key0 = t0; key0 >= 0; key0 -= 32) {
        f32x16 s = qk_tile<4>(Kh, key0, qr, r32, hi);
        float beta[16], keep[16];
#pragma unroll
        for (int r = 0; r < 16; ++r) { beta[r] = fast_rcp(1.0f + fast_exp2(-s[r])); }
        if (key0 == t0) {
#pragma unroll
            for (int r = 0; r < 16; ++r) if (KEY_OF(r, hi) >= r32) beta[r] = 0.f; }
#pragma unroll
        for (int r = 0; r < 16; ++r) keep[r] = 1.0f - beta[r];
        float sufA[8], sufB[8];
        sufA[7] = 1.f; sufB[7] = 1.f;
#pragma unroll
        for (int i = 6; i >= 0; --i) { sufA[i] = sufA[i + 1] * keep[i + 1]; sufB[i] = sufB[i + 1] * keep[8 + i + 1]; }
        const float PA = sufA[0] * keep[0], PB = sufB[0] * keep[8];
        auto ra = __builtin_amdgcn_permlane32_swap(__float_as_uint(PA), __float_as_uint(PA), false, false);
        auto rb = __builtin_amdgcn_permlane32_swap(__float_as_uint(PB), __float_as_uint(PB), false, false);
        const float PA_lo = __uint_as_float(ra[0]), PA_hi = __uint_as_float(ra[1]), PB_lo = __uint_as_float(rb[0]), PB_hi = __uint_as_float(rb[1]);
        const float tB = PB_lo * PB_hi;
        const float multA = carry * tB * (hi ? 1.0f : PA_hi);
        const float multB = carry * (hi ? 1.0f : PB_hi);
#pragma unroll
        for (int i = 0; i < 8; ++i) { s[i] = beta[i] * sufA[i] * multA; s[8 + i] = beta[8 + i] * sufB[i] * multB; }
        carry *= PA_lo * PA_hi * tB;
        const bf16x8 p0 = pack8(s, 0), p1 = pack8(s, 8);
        pv_tile<2>(Vt, T, key0, p0, p1, o, r32, hi);
        if (__builtin_amdgcn_ballot_w64(carry > 9.0e-13f) == 0ull) break;
    }
    bf16* Orow = (bf16*)(F.ws + WS_O) + (size_t)(b * T + t0 + r32) * D + O_C + h * 64;
    store_o<2>(Orow, o, 1.0f, hi);
}
__device__ __forceinline__ void cross_item(const Frame& F, int l, int b, int hx, int qt) {
    const int lane = F.lane, r32 = lane & 31, hi = lane >> 5, r32p = pi32(r32);
    const bf16* Qh = (const bf16*)(F.ws + WS_QX) + (size_t)(b * 4 + hx) * T * 128;
    const bf16* Kh = (const bf16*)(F.ws + WS_KX) + (size_t)((l * NB + b) * 4 + hx) * 256 * 128;
    const bf16* Vt = (const bf16*)(F.ws + WS_VTX) + (size_t)((l * NB + b) * 4 + hx) * 128 * 256;
    const int t0 = qt * 32;
    bf16x8 qr[8]; load_q<8>(qr, Qh, t0, r32, hi);
    float m = -1e30f, lsum = 0.f; f32x16 o[4];
#pragma unroll
    for (int dt = 0; dt < 4; ++dt)
#pragma unroll
        for (int r = 0; r < 16; ++r) o[dt][r] = 0.f;
    bf16x8 kfa[8], kna[8];
    load_k<8>(kfa, Kh, 0, r32, hi);
    for (int kt = 0; kt < 8; ++kt) {
        if (kt + 1 < 8) load_k<8>(kna, Kh, 32 * (kt + 1), r32, hi);
        flash_step<8, 4, false, 0, 0>(kfa, kfa, Vt, 256, 32 * kt, 0, qr, 0.f, m, lsum, o, r32, hi);
        COPY_K(kfa, kna, 8);
    }
    lsum = xhalf_sum(lsum);
    bf16* Orow = (bf16*)(F.ws + WS_OX) + (size_t)(b * T + t0 + r32) * 512 + hx * 128;
    store_o<4>(Orow, o, fast_rcp(lsum), hi);
}
__device__ __forceinline__ void kmean_phase(const Frame& F, float* kmean) {
    LAS float* part = (LAS float*)F.lds;
    for (int vb = blockIdx.x; vb < NB * 4 * 16; vb += F.G) {
        const int blk = vb & 15, bh = vb >> 4;
        const bf16* Kt = (const bf16*)(F.ws + WS_HEADS + HD_KA) + ((size_t)bh * T + blk * 256 + F.wave * 32) * 64 + (size_t)F.lane * 8;
#pragma unroll
        for (int d0 = 0; d0 < 4; ++d0) { const u32x4 w = *(const GAS u32x4*)(Kt + d0 * 512);
            float a[8] = {bflo(w.x), bfhi(w.x), bflo(w.y), bfhi(w.y), bflo(w.z), bfhi(w.z), bflo(w.w), bfhi(w.w)};
#pragma unroll
            for (int i = 0; i < 8; ++i) { a[i] += __shfl_xor(a[i], 1); a[i] += __shfl_xor(a[i], 2); a[i] += __shfl_xor(a[i], 4); a[i] += __shfl_xor(a[i], 8); a[i] += __shfl_xor(a[i], 16); }
            if ((F.lane & 31) == 0) {
#pragma unroll
                for (int i = 0; i < 8; ++i) part[F.wave * 64 + 16 * d0 + 8 * (F.lane >> 5) + i] = a[i]; } }
        __syncthreads();
        if (F.tid < 64) { float s = 0.f;
#pragma unroll
            for (int w = 0; w < 8; ++w) s += part[w * 64 + F.tid];
            kmean[(size_t)vb * 64 + F.tid] = s * (1.0f / 256.0f); }
        __syncthreads();
    }
}
#ifndef MK_PER_PHASE
#define MK_PER_PHASE 0
#endif
constexpr int CW_BAR = 4096;
constexpr int N_PHASES = 31;
struct KvOrder {
    int G, c;
    __device__ __forceinline__ bool next(int i, Unit& u) const { const int L = i * G + c; if (L >= 32) return false; const int l = L >> 4, rem = L & 15;
        u.pm = l * 4 + (rem >> 2); u.pn = rem & 3; u.pb = l * (int)(WL_SIZE / (256 * 1024 * 2)) + (rem & 3); u.po = u.pm; return true; }
};
static_assert(WL_SIZE % (256 * 1024 * 2) == 0, "per-layer weight block must be a whole number of 256 x 1024 bf16 tiles");

struct Args { const float* in[23]; float* out; unsigned char* ws; int ph_lo, ph_hi; };
#define RUN() (lo <= ph && ph < hi)
#define SEAM() do { if (lo <= ph && ph + 1 < hi) { for (int _b = 0; _b < REPS(3); ++_b) xcd_barrier(bar, phase_frame(F0).tid); } ++ph; } while (0)
#define wsb (args.ws)
#define x_in (args.in[0])
#define mem (args.in[1])
#define norm_mix (args.in[2])
#define w_in (args.in[3])
#define w_pa (args.in[4])
#define w_pb (args.in[5])
#define w_pc (args.in[6])
#define w_mix (args.in[7])
#define sinks (args.in[8])
#define norm_cross (args.in[9])
#define norm_mem (args.in[10])
#define w_xq (args.in[11])
#define w_xkv (args.in[12])
#define w_xo (args.in[13])
#define norm_ffn (args.in[14])
#define ffn_gate (args.in[15])
#define ffn_up (args.in[16])
#define ffn_down (args.in[17])
#define moe_router (args.in[18])
#define moe_gate (args.in[19])
#define moe_up (args.in[20])
#define moe_down (args.in[21])
#define final_norm (args.in[22])
#define xres ((bf16*)(wsb + WS_XRES))
#define XN ((bf16*)(wsb + WS_XN))
#define ropec ((float*)(wsb + WS_ROPE))
#define ropes ((float*)(wsb + WS_ROPE) + T * 32)
#define kmean ((float*)(wsb + WS_KMEAN))
#define tok_e ((int*)(wsb + WS_ROUTE + RT_TOKE))
#define tok_w ((float*)(wsb + WS_ROUTE + RT_TOKW))
#define tok_slot ((int*)(wsb + WS_ROUTE + RT_SLOT))
#define rowmap ((int*)(wsb + WS_ROUTE + RT_ROWMAP))
#define meta ((int*)(wsb + WS_ROUTE + RT_META))
template <int l> __device__ __forceinline__ void layer_body(const Args& args, const Frame& F0, const XcdBarrier& bar, const int lo, const int hi, int& ph) {
        unsigned char* wl = wsb + WS_W + (size_t)l * WL_SIZE;
        if (RUN()) for (int rep = 0; rep < REPS(4); ++rep) {
            if (l == 0) { const Frame F = phase_frame(F0);
                pg8::Gemm g{(const bf16*)(wsb + WS_MEMN), (const bf16*)(wsb + WS_W + WL_XKV), D, nullptr}; KvOrder S{F.G, (int)((blockIdx.x + F.G - (INPROJ_I8 ? 192 : ((GATE8_LAYERS >> l) & 1) ? 128 : 64)) % F.G)}; EpiKvMem E{wsb};
                pg8::gemm_phase<EpiKvMem, KvOrder>(F.lds, F.tid, g, S, E); }
            if (INPROJ_I8) { const Frame F = phase_frame(F0);
              pg8::Gemm g{XN, (const bf16*)(wl + WL_IN), D, nullptr}; pg8::StaticOrder S; S.init(M, INW, F.G, (int)blockIdx.x);
              EpiInprojT<true> E{wsb, ropec, ropes, F.lds + RING_BYTES + 1024, (const float*)(wsb + WS_ROUTE + RT_RTOK), (const unsigned*)(wsb + WS_CTL + CTL_CMAX_IN) + l * INW};
              pg8::gemm_phase<EpiInprojT<true>, pg8::StaticOrder, false, true, 2>(F.lds, F.tid, g, S, E); }
            else { const Frame F = phase_frame(F0);
              pg8::Gemm g{XN, (const bf16*)(wl + WL_IN), D, nullptr}; pg8::StaticOrder S; S.init(M, ((GATE8_LAYERS >> l) & 1) ? 2304 : INW, F.G, (int)blockIdx.x); EpiInproj E{wsb, ropec, ropes, F.lds + RING_BYTES + 1024};
              pg8::gemm_phase<EpiInproj, pg8::StaticOrder>(F.lds, F.tid, g, S, E); }
            if ((GATE8_LAYERS >> l) & 1) { const Frame F = phase_frame(F0);
              pg8::Gemm g{(const bf16*)(wsb + WS_XN8), (const bf16*)(wl + WL_IN + WL_IN_G8), D, nullptr}; GateOrder S; S.init(F.G, (int)blockIdx.x, 64); EpiGates8 E{wsb};
              pg8::gemm_phase<EpiGates8, GateOrder, false, true, true>(F.lds, F.tid, g, S, E); }
            if (l == 0 && INPROJ_I8 && rep == 0) { const Frame F = phase_frame(F0); const int c = (int)blockIdx.x;
              if (F.G == 256 && c >= 64 && (c < 192 || c >= 224)) moe_conv_tail(F, 0, c < 192 ? c - 64 : 128 + (c - 224), MOE_TAIL_A0, moe_gate, moe_up, moe_down); }
        }
        SEAM();
        if (RUN()) for (int rep = 0; rep < REPS(6); ++rep) { const Frame F = phase_frame(F0); kmean_phase(F, kmean); }
        SEAM();
        if (RUN()) for (int rep = 0; rep < REPS(1); ++rep) {
            const Frame F = phase_frame(F0);
            for (int vb0 = blockIdx.x; vb0 < 256; vb0 += F.G) {
                const int xc = vb0 & 7, yc = vb0 >> 3; const int vb = ((2 * xc + (yc & 1)) << 4) | (yc >> 1), vbs = xc * 32 + yc;
                { const int bh = vb >> 4, r = vb & 15, j = r >> 1, half = r & 1; const int ob = (F.wave < 4) ? j : 15 - j; const int qt = ob * 8 + half * 4 + (F.wave & 3);
                  if (MOBA_LDS) moba_wg(F, bh >> 2, bh & 3, qt, ((((15 - j) * 8 + half * 4 + 3) >> 1) + 1), kmean); else moba_item(F, bh >> 2, bh & 3, qt, kmean); }
#pragma unroll 1
                for (int k = 0; k < 2; ++k) { const int item = 16 * vbs + 8 * k + F.wave; const int bh = item >> 7; swa_item(F, bh >> 3, bh & 7, item & 127, sinks + l * 8); }
                { const int item = 8 * vb + F.wave; const int bh = item >> 7; sb_item(F, bh >> 2, bh & 3, item & 127); }
            }
        }
        SEAM();
        if (RUN()) for (int rep = 0; rep < REPS(5); ++rep) {
            const Frame F = phase_frame(F0);
            pg8::Gemm g{(const bf16*)(wsb + WS_O), (const bf16*)(wl + WL_PA), D, nullptr}; pg8::StaticOrder S; S.init(M, D, F.G, (int)blockIdx.x);
            EpiGateMix E{(const bf16*)(wsb + WS_G), (bf16*)(wsb + WS_UBF)}; pg8::gemm_phase<EpiGateMix, pg8::StaticOrder>(F.lds, F.tid, g, S, E);
        }
        SEAM();
        if (RUN()) { const Frame F = phase_frame(F0); pg8::Gemm g{(const bf16*)(wsb + WS_UBF), (const bf16*)(wl + WL_MIX), D, nullptr}; pg8::StaticOrder S; S.init(M, D, F.G, (int)blockIdx.x);
            EpiResid<l == 0> E{x_in, xres, xres}; pg8::gemm_phase<EpiResid<l == 0>, pg8::StaticOrder>(F.lds, F.tid, g, S, E); }
        SEAM();
        if (RUN()) for (int rep = 0; rep < REPS(2); ++rep) { const Frame F = phase_frame(F0); if (XQ8) norm_rows<false, true, true, true>(F, xres, norm_cross + l * D, XN, M, nullptr, nullptr, nullptr); else norm_rows<false>(F, xres, norm_cross + l * D, XN, M, nullptr, nullptr, nullptr); }
        SEAM();
        if (RUN()) { const Frame F = phase_frame(F0); pg8::Gemm g{XN, (const bf16*)(wl + WL_XQ), D, nullptr}; pg8::StaticOrder S; S.init(M, XW, F.G, (int)blockIdx.x);
            EpiXq E{(bf16*)(wsb + WS_QX), XQ8 ? QSCALE128 * F8_WINV : QSCALE128}; pg8::gemm_phase<EpiXq, pg8::StaticOrder, false, true, XQ8 != 0>(F.lds, F.tid, g, S, E);
            if (l == 0) { const Frame F2 = phase_frame(F0); const int c = (int)blockIdx.x;
              if (F2.G == 256 && c >= 128) moe_conv_tail(F2, MOE_TAIL_B6, c - 128, MOE_TAIL_A6, moe_gate, moe_up, moe_down); } }
        SEAM();
        if (RUN()) for (int rep = 0; rep < REPS(7); ++rep) {
            const Frame F = phase_frame(F0);
            for (int item = blockIdx.x * NWAVES + F.wave; item < NB * 4 * 128; item += F.G * NWAVES) { const int bh = item >> 7; cross_item(F, l, bh >> 2, bh & 3, item & 127); }
        }
        SEAM();
        if (RUN()) { const Frame F = phase_frame(F0); pg8::Gemm g{(const bf16*)(wsb + WS_OX), (const bf16*)(wl + WL_XO), XW, nullptr}; pg8::StaticOrder S; S.init(M, D, F.G, (int)blockIdx.x);
            EpiResid<false> E{nullptr, xres, xres}; pg8::gemm_phase<EpiResid<false>, pg8::StaticOrder>(F.lds, F.tid, g, S, E); }
        SEAM();
        if (l == 0) {
            if (RUN()) for (int rep = 0; rep < REPS(2); ++rep) { const Frame F = phase_frame(F0); norm_rows<false, true, true, 2>(F, xres, norm_ffn, XN, M, nullptr, nullptr, nullptr, nullptr, nullptr, (float*)(wsb + WS_ROUTE + RT_RTOK)); }
            SEAM();
            if (RUN()) for (int rep = 0; rep < REPS(9); ++rep) { const Frame F = phase_frame(F0); pg8::Gemm g{XN, (const bf16*)(wsb + WS_FFN_GU), D, nullptr}; pg8::StaticOrder S; S.init(M, 2 * DFF, F.G, (int)blockIdx.x);
                EpiSwigluI8 E{(bf16*)(wsb + WS_HFFN), HFFN_LD, (const float*)(wsb + WS_ROUTE + RT_RTOK), (const unsigned*)(wsb + WS_CTL + CTL_CMAX)}; pg8::gemm_phase<EpiSwigluI8, pg8::StaticOrder, false, true, 2>(F.lds, F.tid, g, S, E);
                if (rep == 0) { const Frame F2 = phase_frame(F0); const int c = (int)blockIdx.x;
                  if (F2.G == 256 && c >= 128) moe_conv_tail(F2, MOE_TAIL_B10, c - 128, MOE_TAIL_A10, moe_gate, moe_up, moe_down); } }
            SEAM();
            if (RUN()) for (int rep = 0; rep < REPS(12); ++rep) { const Frame F = phase_frame(F0); pg8::Gemm g{(const bf16*)(wsb + WS_HFFN), (const bf16*)(wsb + WS_FFN_DN), DFF, nullptr, HFFN_LD, HFFN_LD}; pg8::StaticOrder S; S.init(M, D, F.G, (int)blockIdx.x);
                EpiResid<false> E{nullptr, xres, (rep + 1 < REPS(12)) ? (bf16*)(wsb + WS_G + 32 * MiB) : xres}; pg8::gemm_phase<EpiResid<false>, pg8::StaticOrder>(F.lds, F.tid, g, S, E); }
            SEAM();
            if (RUN()) for (int rep = 0; rep < REPS(2); ++rep) { const Frame F = phase_frame(F0); if (INPROJ_I8) norm_rows<false, true, true, 2>(F, xres, norm_mix + D, XN, M, nullptr, nullptr, nullptr, nullptr, nullptr, (float*)(wsb + WS_ROUTE + RT_RTOK));
                else if (GATE8_LAYERS & 2) norm_rows<false, true, true, false, true>(F, xres, norm_mix + D, XN, M, nullptr, nullptr, nullptr, nullptr, wsb + WS_XN8); else norm_rows<false>(F, xres, norm_mix + D, XN, M, nullptr, nullptr, nullptr); }
            SEAM();
        } else {
            if (RUN()) { const Frame F = phase_frame(F0); norm_rows<true, true, true, true>(F, xres, norm_ffn + D, XN, M, moe_router, tok_e, tok_w); }
            SEAM();
            if (RUN()) { const Frame F = phase_frame(F0); if (blockIdx.x == 0) moe_route(F, tok_e, tok_slot, rowmap, meta); }
            SEAM();
            const bool any_moe = (lo <= ph + 3 && ph < hi);
            const int RT = any_moe ? meta[0] : 0;
            const int n0c = RT < MOE_CHUNK_RT ? RT : MOE_CHUNK_RT, rem = RT - n0c, X = (rem > MOE_CHUNK_RT) ? MOE_X : 0, n1 = rem - X;
            if (RUN()) for (int rep = 0; rep < REPS(10); ++rep) { const Frame F = phase_frame(F0); pg8::Gemm g{XN, (const bf16*)(wsb + WS_MOE_GU), D, rowmap}; pg8::MoeOrder<true> S; S.init(n0c + X, 2 * DFE, F.G, (int)blockIdx.x, n0c, 0, n0c + n1, 0, 0, meta + 16);
                EpiSwiglu8 E{wsb + WS_HMOE, DFE}; pg8::gemm_phase<EpiSwiglu8, pg8::MoeOrder<true>, true, true, true>(F.lds, F.tid, g, S, E); }
            SEAM();
            if (RUN()) { const Frame F = phase_frame(F0); pg8::Gemm g{(const bf16*)(wsb + WS_HMOE), (const bf16*)(wsb + WS_MOE_DN), DFE, nullptr}; pg8::MoeOrder<false> S; S.init(n0c, D, F.G, (int)blockIdx.x, n0c, 0, 0, 0, 0, meta + 16);
                EpiBf16Out E{(bf16*)(wsb + WS_Y), D, F8_WINV}; pg8::gemm_phase<EpiBf16Out, pg8::MoeOrder<false>, false, true, true>(F.lds, F.tid, g, S, E); }
            SEAM();
            if (RUN()) {
                { const Frame F = phase_frame(F0); pg8::Gemm g{(const bf16*)(wsb + WS_HMOE), (const bf16*)(wsb + WS_MOE_DN), DFE, nullptr}; pg8::MoeOrder<false> S; S.init(X, D, F.G, (int)blockIdx.x, X, n0c + n1, 0, n0c, 0, meta + 16);
                  EpiBf16Out E{(bf16*)(wsb + WS_Y), D, F8_WINV}; pg8::gemm_phase<EpiBf16Out, pg8::MoeOrder<false>, false, true, true>(F.lds, F.tid, g, S, E); }
                { const Frame F = phase_frame(F0); pg8::Gemm g{XN, (const bf16*)(wsb + WS_MOE_GU), D, rowmap}; pg8::MoeOrder<true> S; S.init(n1, 2 * DFE, F.G, (int)blockIdx.x, n1, n0c, 0, 0, 4 * X, meta + 16);
                  EpiSwiglu8 E{wsb + WS_HMOE, DFE}; pg8::gemm_phase<EpiSwiglu8, pg8::MoeOrder<true>, true, true, true>(F.lds, F.tid, g, S, E); }
            }
            SEAM();
            if (RUN()) { const Frame F = phase_frame(F0); pg8::Gemm g{(const bf16*)(wsb + WS_HMOE), (const bf16*)(wsb + WS_MOE_DN), DFE, nullptr}; pg8::MoeOrder<false> S; S.init(n1, D, F.G, (int)blockIdx.x, n1, n0c, 0, 0, 0, meta + 16);
                EpiBf16Out E{(bf16*)(wsb + WS_Y), D, F8_WINV}; pg8::gemm_phase<EpiBf16Out, pg8::MoeOrder<false>, false, true, true>(F.lds, F.tid, g, S, E); }
            SEAM();
            if (RUN()) { const Frame F = phase_frame(F0); combine_final(F, xres, (const bf16*)(wsb + WS_Y), tok_slot, tok_w, final_norm, args.out); }
            SEAM();
        }
}
__global__ void __launch_bounds__(NWAVES * 64, 2) mk_fwd(Args args) {
    extern __shared__ __attribute__((aligned(16))) unsigned char lds_raw[];
    Frame F0;
    F0.lds = (LAS unsigned char*)lds_raw;
    { const int t0 = threadIdx.x; F0.tid = 0; F0.lane = 0; F0.wave = __builtin_amdgcn_readfirstlane(t0 >> 6); F0.G = gridDim.x; F0.ws = args.ws;
      for (int u = t0; u < (LDS_BYTES - RING_BYTES) / 4; u += NWAVES * 64) ((LAS unsigned*)(F0.lds + RING_BYTES))[u] = 0u; }
    volatile LAS unsigned* MISC = (volatile LAS unsigned*)(F0.lds + MISC_OFF);
    __syncthreads();
    unsigned* ctl = (unsigned*)(args.ws + WS_CTL);
    XcdBarrier bar = xcd_barrier_post(ctl + CW_BAR, MISC + 8, phase_frame(F0).tid);
    const int lo = args.ph_lo, hi = args.ph_hi;
    int ph = 0;
    if (RUN()) { const Frame F = phase_frame(F0); int rot = 0; colmax_matrix<2>(F, rot, ffn_gate, ffn_up, DFF, D, 2 * DFF, (unsigned*)(wsb + WS_CTL + CTL_CMAX));
        if (INPROJ_I8) for (int l = 0; l < 2; ++l) colmax_matrix<1>(F, rot, w_in + (size_t)l * D * INW, nullptr, INW, D, INW, (unsigned*)(wsb + WS_CTL + CTL_CMAX_IN) + l * INW); }
    SEAM();
    if (RUN()) for (int rep = 0; rep < REPS(0); ++rep) {
        const Frame F = phase_frame(F0);
        LAS float* scr = (LAS float*)(F.lds + F.wave * 16896);
        LAS float* scr8 = scr;
        { const int gt = blockIdx.x * (NWAVES * 64) + F.tid, NT = F.G * NWAVES * 64;
          for (int idx = gt; idx < T * 32; idx += NT) { const int pos = idx >> 5, i = idx & 31; const float inv = powf(10000.0f, -(float)i / 32.0f); const float ang = (float)pos * inv;
              ropec[idx] = cosf(ang); ropes[idx] = sinf(ang); } }
        int rot = 0;
        transpose_matrix<2, 2>(F, rot, ffn_gate, ffn_up, DFF, D, 2 * DFF, (bf16*)(wsb + WS_FFN_GU), scr, 0, (const unsigned*)(wsb + WS_CTL + CTL_CMAX));
        if (INPROJ_I8) for (int l = 0; l < 2; ++l) transpose_matrix<1, 2>(F, rot, w_in + (size_t)l * D * INW, nullptr, INW, D, INW, (bf16*)(wsb + WS_W + (size_t)l * WL_SIZE + WL_IN), scr, 0, (const unsigned*)(wsb + WS_CTL + CTL_CMAX_IN) + l * INW);
        {
            const int NGW = F.G * NWAVES, q0 = (F.G == 256) ? MOE_TAIL_ITEMS : 0; int gw = blockIdx.x * NWAVES + F.wave - rot; if (gw < 0) gw += NGW;
            for (int q = q0 + gw; q < MOE_ITEMS; q += NGW) moe_conv_item(q, moe_gate, moe_up, moe_down, wsb, scr8, F.lane);
            rot = (rot + (MOE_ITEMS - q0)) % NGW;
        }
        transpose_matrix<0>(F, rot, ffn_down, nullptr, D, DFF, D, (bf16*)(wsb + WS_FFN_DN), scr, HFFN_LD);
        for (int l = 0; l < 2; ++l) {
            unsigned char* wl = wsb + WS_W + (size_t)l * WL_SIZE;
            if (INPROJ_I8) { }
            else if ((GATE8_LAYERS >> l) & 1) { transpose_matrix<1>(F, rot, w_in + (size_t)l * D * INW, nullptr, INW, D, 2304, (bf16*)(wl + WL_IN), scr);
                transpose_matrix<0, true>(F, rot, w_in + (size_t)l * D * INW + 2304, nullptr, INW, D, 3072, (bf16*)(wl + WL_IN + WL_IN_G8), scr); }
            else transpose_matrix<1>(F, rot, w_in + (size_t)l * D * INW, nullptr, INW, D, INW, (bf16*)(wl + WL_IN), scr);
            transpose_matrix<0>(F, rot, w_pa + (size_t)l * 256 * D, nullptr, D, 256, D, (bf16*)(wl + WL_PA), scr, D);
            transpose_matrix<0>(F, rot, w_pb + (size_t)l * 512 * D, nullptr, D, 512, D, (bf16*)(wl + WL_PA) + 256, scr, D);
            transpose_matrix<0>(F, rot, w_pc + (size_t)l * 256 * D, nullptr, D, 256, D, (bf16*)(wl + WL_PA) + 768, scr, D);
            transpose_matrix<0>(F, rot, w_mix + (size_t)l * D * D, nullptr, D, D, D, (bf16*)(wl + WL_MIX), scr);
            transpose_matrix<0, XQ8 != 0>(F, rot, w_xq + (size_t)l * D * XW, nullptr, XW, D, XW, (bf16*)(wl + WL_XQ), scr);
            transpose_matrix<0>(F, rot, w_xkv + (size_t)l * D * 2 * XW, nullptr, 2 * XW, D, 2 * XW, (bf16*)(wl + WL_XKV), scr);
            transpose_matrix<0>(F, rot, w_xo + (size_t)l * XW * D, nullptr, D, XW, D, (bf16*)(wl + WL_XO), scr);
            norm_rows<false, false>(F, mem, norm_mem + l * D, (bf16*)(wsb + WS_MEMN) + (size_t)l * NB * MEML * D, NB * MEML, nullptr, nullptr, nullptr);
        }
        if (INPROJ_I8) norm_rows<false, false, true, 2>(F, x_in, norm_mix, XN, M, nullptr, nullptr, nullptr, nullptr, nullptr, (float*)(wsb + WS_ROUTE + RT_RTOK));
        else if (GATE8_LAYERS & 1) norm_rows<false, false, true, false, true>(F, x_in, norm_mix, XN, M, nullptr, nullptr, nullptr, nullptr, wsb + WS_XN8); else norm_rows<false, false>(F, x_in, norm_mix, XN, M, nullptr, nullptr, nullptr);
    }
    SEAM();

    layer_body<0>(args, F0, bar, lo, hi, ph);
    layer_body<1>(args, F0, bar, lo, hi, ph);
#undef RUN
#undef SEAM
}
#undef wsb
#undef x_in
#undef mem
#undef xres
#undef XN
#undef ropec
#undef ropes
#undef kmean
#undef tok_e
#undef tok_w
#undef tok_slot
#undef rowmap
#undef meta
#undef sinks
#undef norm_mix
#undef w_in
#undef w_pa
#undef w_pb
#undef w_pc
#undef w_mix
#undef norm_cross
#undef norm_mem
#undef w_xq
#undef w_xkv
#undef w_xo
#undef norm_ffn
#undef ffn_gate
#undef ffn_up
#undef ffn_down
#undef moe_router
#undef moe_gate
#undef moe_up
#undef moe_down
#undef final_norm

extern "C" void kernel_launch(void* const* d_in, const int* in_sizes, int n_in, void* d_out, int out_size, void* d_ws, size_t ws_size, hipStream_t stream) {
    static int grid = 0;
    if (grid == 0) {
        if (n_in != 23 || in_sizes[0] != M * D || out_size != M * D || ws_size < WS_END) { fprintf(stderr, "kernel_launch: unexpected shapes / workspace (n_in %d, wsb %zu < %zu); nothing launched\n", n_in, ws_size, (size_t)WS_END); grid = -1; return; }
        int dev = 0, cus = 0, per_cu = 0;
        if (hipGetDevice(&dev) != hipSuccess || hipDeviceGetAttribute(&cus, hipDeviceAttributeMultiprocessorCount, dev) != hipSuccess) { grid = -1; return; }
        if (hipFuncSetAttribute((const void*)mk_fwd, hipFuncAttributeMaxDynamicSharedMemorySize, LDS_BYTES) != hipSuccess) { fprintf(stderr, "kernel_launch: hipFuncSetAttribute failed\n"); grid = -1; return; }
        if (hipOccupancyMaxActiveBlocksPerMultiprocessor(&per_cu, (const void*)mk_fwd, NWAVES * 64, LDS_BYTES) != hipSuccess || per_cu < 1)
            fprintf(stderr, "kernel_launch: note: occupancy query reports %d workgroups per CU\n", per_cu);
        (void)hipGetLastError();
        grid = cus;
    }
    if (grid < 0) return;
    if (hipMemsetAsync((char*)d_ws + WS_CTL, 0, CTL_ZERO_BYTES, stream) != hipSuccess) return;
    Args a{};
    for (int i = 0; i < 23; ++i) a.in[i] = (const float*)d_in[i];
    a.out = (float*)d_out; a.ws = (unsigned char*)d_ws;
#if MK_PER_PHASE
    for (int k = 0; k < N_PHASES; ++k) { a.ph_lo = k; a.ph_hi = k + 1; hipLaunchKernelGGL(mk_fwd, dim3(grid), dim3(NWAVES * 64), LDS_BYTES, stream, a); }
#else
    a.ph_lo = 0; a.ph_hi = N_PHASES; hipLaunchKernelGGL(mk_fwd, dim3(grid), dim3(NWAVES * 64), LDS_BYTES, stream, a);
#endif
}
```

```cpp
#include <hip/hip_runtime.h>
#include <cstdio>
#include <cstdint>
#include <cmath>

#ifndef PROBE_DOUBLE
#define PROBE_DOUBLE 0
#endif
#define REPS(bit) (1 + ((PROBE_DOUBLE >> (bit)) & 1))
#ifndef XQ8
#define XQ8 1
#endif
#ifndef MOBA_LDS
#define MOBA_LDS 0
#endif
#ifndef INPROJ_I8
#define INPROJ_I8 1
#endif
#ifndef GATE8_LAYERS
#define GATE8_LAYERS (INPROJ_I8 ? 0 : 3)
#endif
#define LAS __attribute__((address_space(3)))
#define GAS __attribute__((address_space(1)))
typedef unsigned short bf16;
typedef short bf16x8 __attribute__((ext_vector_type(8)));
typedef float f32x4 __attribute__((ext_vector_type(4)));
typedef float f32x2 __attribute__((ext_vector_type(2)));
typedef float f32x16 __attribute__((ext_vector_type(16)));
typedef unsigned u32x4 __attribute__((ext_vector_type(4)));
typedef unsigned u32x2 __attribute__((ext_vector_type(2)));
typedef int i32x8 __attribute__((ext_vector_type(8)));
typedef int i32x4 __attribute__((ext_vector_type(4)));

constexpr int NB = 4, T = 4096, M = NB * T, D = 1024, INW = 5376;
constexpr int MEML = 256, XW = 512, DFF = 2816, NE = 8, DFE = 3584;
constexpr float EPS = 1e-6f;
constexpr float LOG2E = 1.4426950408889634f;
constexpr float QSCALE64 = 0.125f * LOG2E;
constexpr float QSCALE128 = 0.08838834764831845f * LOG2E;

typedef __bf16 bf16x2_t __attribute__((ext_vector_type(2)));
__device__ __forceinline__ unsigned cvt_pk_bf16(float lo, float hi) { f32x2 v = {lo, hi}; bf16x2_t b = __builtin_convertvector(v, bf16x2_t); return __builtin_bit_cast(unsigned, b); }
__device__ __forceinline__ float bf2f(unsigned short b) { return __uint_as_float((unsigned)b << 16); }
__device__ __forceinline__ float bflo(unsigned w) { return __uint_as_float(w << 16); }
__device__ __forceinline__ float bfhi(unsigned w) { return __uint_as_float(w & 0xffff0000u); }
__device__ __forceinline__ float fast_exp2(float x) { return __builtin_amdgcn_exp2f(x); }
__device__ __forceinline__ float fast_rcp(float x) { return __builtin_amdgcn_rcpf(x); }
__device__ __forceinline__ float sigmoidf_fast(float x) { return fast_rcp(1.0f + fast_exp2(-x * LOG2E)); }

constexpr float F8_WSCALE = 64.0f, F8_WINV = 1.0f / 64.0f;
__device__ __forceinline__ float f8clamp(float v) { return __builtin_amdgcn_fmed3f(v, -448.f, 448.f); }
__device__ __forceinline__ unsigned cvt_pk4_fp8(float a, float b, float c, float d) {
    int p = __builtin_amdgcn_cvt_pk_fp8_f32(f8clamp(a), f8clamp(b), 0, false); p = __builtin_amdgcn_cvt_pk_fp8_f32(f8clamp(c), f8clamp(d), p, true); return (unsigned)p; }
__device__ __forceinline__ void st16(void* p, u32x4 v) { *(GAS u32x4*)p = v; }
__device__ __forceinline__ void st16(void* p, f32x4 v) { *(GAS f32x4*)p = v; }
__device__ __forceinline__ void st8(void* p, u32x2 v) { *(GAS u32x2*)p = v; }

namespace pg8 {
constexpr int BM = 256, BK = 64, HALF = 128, HTB = HALF * BK * 2, STAGE_BYTES = 8 * HTB, NXCD = 8, WGM = 8;
__host__ __device__ __forceinline__ int lds_byte(int r, int c) { const int st = (r >> 4) * 2 + (c >> 5), rr = r & 15, cc = c & 31, ob = rr * 64 + cc * 2; return st * 1024 + (ob ^ (((ob >> 9) & 1) << 5)); }
__host__ __device__ __forceinline__ void stage_rc(int b, int& R, int& C) { const int st = b / 1024, sb = b % 1024, swz = sb ^ (((sb >> 9) & 1) << 5); R = (st >> 1) * 16 + swz / 64; C = (st & 1) * 32 + (swz % 64) / 2; }
__host__ __device__ __forceinline__ int perm32(int rho) { const int n = rho >> 4, i = rho & 15; return 8 * (i >> 2) + 4 * n + (i & 3); }

struct Unit { int pm, pn, pb, po; };
struct Gemm { const bf16* A; const bf16* Bt; int K; const int* rowmap; int lda = 0, ldb = 0; };

struct StaticOrder {
    int nM, nN, nwg, G, c;
    __device__ void init(int M_, int N_, int G_, int c_) { nM = M_ / BM; nN = N_ / BM; nwg = nM * nN; G = G_; c = c_; }
    __device__ __forceinline__ bool next_mn(int i, int& pm, int& pn) const { return next_L((long)i * G + c, pm, pn); }
    __device__ __forceinline__ bool next_L(long L, int& pm, int& pn) const {
        if (L >= nwg) return false;
        int wgid = (int)L; { const int q = nwg / NXCD, r = nwg % NXCD, xcd = wgid % NXCD, off = wgid / NXCD; wgid = (xcd < r ? xcd * (q + 1) : r * (q + 1) + (xcd - r) * q) + off; }
        const int nig = WGM * nN, gid = wgid / nig, fm = gid * WGM, gsz = (nM - fm) < WGM ? (nM - fm) : WGM;
        pm = fm + ((wgid % nig) % gsz); pn = (wgid % nig) / gsz; return true;
    }
    __device__ __forceinline__ bool next(int i, Unit& u) const { int pm, pn; if (!next_mn(i, pm, pn)) return false; u.pm = pm; u.pn = pn; u.pb = pn; u.po = pm; return true; }
};
template <bool UP> struct MoeOrder {
    StaticOrder so; int n0, rtA, rtB, hbase, nd; const int* tile_expert; int nNexp;
    __device__ void init(int ntiles, int N_, int G_, int c_, int n0_, int rtA_, int rtB_, int hbase_, int nd_, const int* te) { so.init(ntiles * BM, N_, G_, c_); n0 = n0_; rtA = rtA_; rtB = rtB_; hbase = hbase_; nd = nd_; tile_expert = te; nNexp = N_ / BM; }
    __device__ __forceinline__ bool next(int i, Unit& u) const {
        long L;
        if (nd == 0) L = (long)i * so.G + so.c;
        else { const int r = (so.c < nd) ? i + 3 : i; if (r < 3) L = (long)r * (so.G - nd) + (so.c - nd); else L = 3L * (so.G - nd) + (long)(r - 3) * so.G + so.c; }
        int pm, pn; if (!so.next_L(L, pm, pn)) return false;
        const int rt = pm < n0 ? rtA + pm : rtB + (pm - n0); const int e = __builtin_amdgcn_readfirstlane(tile_expert[rt]);
        u.pn = pn; u.pb = e * nNexp + pn; if (UP) { u.pm = rt; u.po = hbase + pm; } else { u.pm = hbase + pm; u.po = rt; } return true; }
};

template <class Epi, class Sched, bool GATHER = false, bool ALIGN_EPI = true, int MODE = 0>
__device__ __forceinline__ void gemm_phase(LAS unsigned char* lds, const int tid  , const Gemm g, const Sched& S, const Epi& E) {
    const int wid = __builtin_amdgcn_readfirstlane(tid >> 6), lane = tid & 63, wr = wid >> 2, wc = wid & 3, fr = lane & 15, fq = lane >> 4;
    constexpr bool F8 = (MODE == 1), I8 = (MODE == 2);
    constexpr int EB = MODE ? 1 : 2;
    const int K = g.K, nt = K / (MODE ? 2 * BK : BK), lda = (g.lda ? g.lda : K) * EB, ldb = (g.ldb ? g.ldb : K) * EB;
    unsigned voffA[2], voffB[2];
#pragma unroll
    for (int i = 0; i < 2; ++i) { int R, C; stage_rc(tid * 16 + i * 8192, R, C); const int Rb = Epi::PERM ? ((R & ~31) + perm32(R & 31)) : R; voffA[i] = (unsigned)(R * lda + C * 2); voffB[i] = (unsigned)(Rb * ldb + C * 2); }
    const size_t kstep = (size_t)(BK * 2);
    const size_t hstepA = (size_t)HALF * lda, hstep = (size_t)HALF * ldb;
    const size_t tstepA = 2 * hstepA, tstep = 2 * hstep;
    const unsigned ldsw = (unsigned)wid * 1024u;
    const int aoff = lds_byte(wr * 64 + fr, fq * 8), boff = lds_byte(wc * 32 + fr, fq * 8);
#define PG8_SA(b, h) (((b) * 2 + (h)) * HTB)
#define PG8_SB(b, h) ((4 + (b) * 2 + (h)) * HTB)
#define PG8_STAGE(bufoff, gbase, voff) do { _Pragma("unroll") for (int _i = 0; _i < 2; ++_i) \
        __builtin_amdgcn_global_load_lds((const unsigned*)((const char*)(gbase) + (voff)[_i]), (LAS unsigned*)(lds + (bufoff) + ldsw + _i * 8192), 16, 0, 0); } while (0)
#define PG8_LDA(dst, b, h) do { _Pragma("unroll") for (int m = 0; m < 4; ++m) { if constexpr (F8) { dst##8[m].lo = *(const LAS i32x4*)(lds + PG8_SA(b, h) + aoff + m * 2048); dst##8[m].hi = *(const LAS i32x4*)(lds + PG8_SA(b, h) + aoff + m * 2048 + 1024); } \
        else { _Pragma("unroll") for (int k = 0; k < 2; ++k) dst[m][k] = *(const LAS bf16x8*)(lds + PG8_SA(b, h) + aoff + m * 2048 + k * 1024); } } } while (0)
#define PG8_LDB(dst, b, h) do { _Pragma("unroll") for (int n = 0; n < 2; ++n) { if constexpr (F8) { dst##8[n].lo = *(const LAS i32x4*)(lds + PG8_SB(b, h) + boff + n * 2048); dst##8[n].hi = *(const LAS i32x4*)(lds + PG8_SB(b, h) + boff + n * 2048 + 1024); } \
        else { _Pragma("unroll") for (int k = 0; k < 2; ++k) dst[n][k] = *(const LAS bf16x8*)(lds + PG8_SB(b, h) + boff + n * 2048 + k * 1024); } } } while (0)
#define PG8_MMA(ai, bj, At, Bt) do { __builtin_amdgcn_s_setprio(1); _Pragma("unroll") for (int m = 0; m < 4; ++m) _Pragma("unroll") for (int n = 0; n < 2; ++n) { if constexpr (F8) \
        asm volatile("v_mfma_f32_16x16x128_f8f6f4 %0, %1, %2, %0" : "+v"(acc[ai][bj][m][n]) : "v"(Bt##8[n]), "v"(At##8[m])); else if constexpr (I8) { _Pragma("unroll") for (int k = 0; k < 2; ++k) \
        acc[ai][bj][m][n] = __builtin_bit_cast(f32x4, __builtin_amdgcn_mfma_i32_16x16x64_i8(__builtin_bit_cast(i32x4, Bt[n][k]), __builtin_bit_cast(i32x4, At[m][k]), __builtin_bit_cast(i32x4, acc[ai][bj][m][n]), 0, 0, 0)); } else { _Pragma("unroll") for (int k = 0; k < 2; ++k) \
        acc[ai][bj][m][n] = __builtin_amdgcn_mfma_f32_16x16x32_bf16(Bt[n][k], At[m][k], acc[ai][bj][m][n], 0, 0, 0); } } __builtin_amdgcn_s_setprio(0); } while (0)
#define PG8_WAIT_V(n) asm volatile("s_waitcnt vmcnt(" #n ")" ::: "memory")
#define PG8_WAIT_L(n) asm volatile("s_waitcnt lgkmcnt(" #n ")" ::: "memory")
#define PG8_BAR __builtin_amdgcn_s_barrier()
#define PG8_SCHED __builtin_amdgcn_sched_barrier(0)
    LAS int* rmL = (LAS int*)(lds + 131072 + 12288);
#define PG8_RMDMA(b, u) __builtin_amdgcn_global_load_lds((const unsigned*)(g.rowmap + (u).pm * BM + (wid & 3) * 64 + lane), (LAS unsigned*)(rmL + (b) * 256 + (wid & 3) * 64), 4, 0, 0)
#define PG8_GOFFS(vo, b) do { _Pragma("unroll") for (int _h = 0; _h < 2; ++_h) _Pragma("unroll") for (int _i = 0; _i < 2; ++_i) { int _R, _C; stage_rc(tid * 16 + _i * 8192, _R, _C); \
        const int _row = rmL[(b) * 256 + _h * HALF + _R]; vo[_h][_i] = (unsigned)(_row * lda + _C * 2); } } while (0)
#define PG8_STAGE_A(bufoff, p, h, nextu) do { if constexpr (GATHER) { if (nextu) PG8_STAGE(bufoff, p, voN[h]); else PG8_STAGE(bufoff, p, voC[h]); } else PG8_STAGE(bufoff, (p) + (h) * hstepA, voffA); } while (0)
    Unit cur, nxt; int ui = 0;
    if (!S.next(0, cur)) return;
    f32x4 acc[2][2][4][2];
#pragma unroll
    for (int a = 0; a < 2; ++a)
#pragma unroll
        for (int b = 0; b < 2; ++b)
#pragma unroll
            for (int m = 0; m < 4; ++m)
#pragma unroll
                for (int n = 0; n < 2; ++n) acc[a][b][m][n] = (f32x4){0.f, 0.f, 0.f, 0.f};
    bf16x8 At[4][2], B0[2][2], B1[2][2];
    i32x8 At8[4], B08[2], B18[2];
    unsigned voC[2][2], voN[2][2];
    if constexpr (GATHER) { PG8_RMDMA(0, cur); PG8_WAIT_V(0); PG8_BAR; PG8_GOFFS(voC, 0); }
    const char* cA = GATHER ? (const char*)g.A : (const char*)g.A + (size_t)cur.pm * tstepA; const char* cB = (const char*)g.Bt + (size_t)cur.pb * tstep;
    PG8_STAGE(PG8_SB(0, 0), cB, voffB); PG8_STAGE(PG8_SB(0, 1), cB + hstep, voffB); PG8_STAGE_A(PG8_SA(0, 0), cA, 0, false); PG8_STAGE_A(PG8_SA(0, 1), cA, 1, false);
    if (wr == 1) PG8_BAR;
    PG8_WAIT_V(2); PG8_BAR;
    PG8_STAGE(PG8_SB(1, 0), cB + kstep, voffB); PG8_STAGE_A(PG8_SA(1, 0), cA + kstep, 0, false); PG8_STAGE(PG8_SB(1, 1), cB + hstep + kstep, voffB);
    PG8_WAIT_V(6); PG8_BAR;
    for (;;) {
        const bool has_next = S.next(ui + 1, nxt);
        if constexpr (GATHER) { if (has_next) PG8_RMDMA((ui + 1) & 1, nxt); }
        const char* nA = GATHER ? cA : (has_next ? (const char*)g.A + (size_t)nxt.pm * tstepA : cA); const char* nB = has_next ? (const char*)g.Bt + (size_t)nxt.pb * tstep : cB;
#pragma clang loop unroll(disable)
        for (int t = 0; t < nt; t += 2) {
            const bool last = (t == nt - 2);
            if constexpr (GATHER) { if (last) { if (has_next) { PG8_GOFFS(voN, (ui + 1) & 1); } else {
#pragma unroll
                for (int _h = 0; _h < 2; ++_h)
#pragma unroll
                    for (int _i = 0; _i < 2; ++_i) voN[_h][_i] = voC[_h][_i]; } } }
            const char* a1 = cA + (size_t)(t + 1) * kstep;
            const char* a2 = last ? nA : cA + (size_t)(t + 2) * kstep; const char* b2 = last ? nB : cB + (size_t)(t + 2) * kstep;
            const char* a3 = a2 + kstep; const char* b3 = b2 + kstep;
            PG8_LDB(B0, 0, 0); PG8_LDB(B1, 0, 1); PG8_SCHED; PG8_LDA(At, 0, 0); PG8_STAGE_A(PG8_SA(1, 1), a1, 1, false);
            PG8_WAIT_V(8); PG8_WAIT_L(0); PG8_BAR; PG8_MMA(0, 0, At, B0); PG8_MMA(0, 1, At, B1); PG8_BAR; PG8_SCHED;
            PG8_LDA(At, 0, 1); PG8_STAGE(PG8_SB(0, 0), b2, voffB); PG8_STAGE(PG8_SB(0, 1), b2 + hstep, voffB); PG8_STAGE_A(PG8_SA(0, 0), a2, 0, last);
            PG8_WAIT_V(8); PG8_WAIT_L(0); PG8_BAR; PG8_MMA(1, 0, At, B0); PG8_MMA(1, 1, At, B1); PG8_BAR; PG8_SCHED;
            PG8_LDB(B0, 1, 0); PG8_LDB(B1, 1, 1); PG8_SCHED; PG8_LDA(At, 1, 0); PG8_STAGE_A(PG8_SA(0, 1), a2, 1, last);
            PG8_WAIT_V(8); PG8_WAIT_L(0); PG8_BAR; PG8_MMA(0, 0, At, B0); PG8_MMA(0, 1, At, B1); PG8_BAR; PG8_SCHED;
            PG8_LDA(At, 1, 1); PG8_STAGE(PG8_SB(1, 0), b3, voffB); PG8_STAGE(PG8_SB(1, 1), b3 + hstep, voffB); PG8_STAGE_A(PG8_SA(1, 0), a3, 0, last);
            PG8_WAIT_V(8); PG8_WAIT_L(0); PG8_BAR; PG8_MMA(1, 0, At, B0); PG8_MMA(1, 1, At, B1); PG8_BAR; PG8_SCHED;
            if constexpr (Epi::HAS_MID) { if (E.is_mid(t + 2)) E.mid(acc, cur, t + 2, wr, wc, fr, fq); }
        }
        if constexpr (ALIGN_EPI) { if (wr == 0) PG8_BAR; }
        if constexpr (F8) asm volatile("s_nop 15\n\ts_nop 15" ::: "memory");
        E(acc, cur, wr, wc, fr, fq);
        if (!has_next) break;
#pragma unroll
        for (int a = 0; a < 2; ++a)
#pragma unroll
            for (int b = 0; b < 2; ++b)
#pragma unroll
                for (int m = 0; m < 4; ++m)
#pragma unroll
                    for (int n = 0; n < 2; ++n) acc[a][b][m][n] = (f32x4){0.f, 0.f, 0.f, 0.f};
        cur = nxt; cA = nA; cB = nB; ++ui;
        if constexpr (GATHER) {
#pragma unroll
            for (int _h = 0; _h < 2; ++_h)
#pragma unroll
                for (int _i = 0; _i < 2; ++_i) voC[_h][_i] = voN[_h][_i]; }
        if constexpr (ALIGN_EPI) { if (wr == 1) PG8_BAR; }
    }
    PG8_WAIT_V(0);
    if constexpr (!ALIGN_EPI) { if (wr == 0) PG8_BAR; }
    PG8_BAR;
#undef PG8_GOFFS
#undef PG8_RMDMA
#undef PG8_STAGE_A
#undef PG8_SA
#undef PG8_SB
#undef PG8_STAGE
#undef PG8_LDA
#undef PG8_LDB
#undef PG8_MMA
#undef PG8_WAIT_V
#undef PG8_WAIT_L
#undef PG8_BAR
#undef PG8_SCHED
}
}
constexpr size_t MiB = 1u << 20;
constexpr size_t WS_CTL = 0, CTL_ZERO_BYTES = 1 * MiB;
constexpr size_t CTL_CMAX_IN = 98304;
constexpr size_t CTL_CMAX = 65536;
constexpr size_t WS_ROPE = 1 * MiB;
constexpr size_t WS_KMEAN = 2 * MiB;
constexpr size_t WS_ROUTE = 3 * MiB;
constexpr size_t RT_TOKE = 0, RT_TOKW = 128 * 1024, RT_SLOT = 256 * 1024, RT_ROWMAP = 384 * 1024, RT_META = 640 * 1024, RT_RTOK = 704 * 1024  , RT_RSLOT = 768 * 1024  ;
constexpr size_t WS_W = 4 * MiB;
constexpr size_t WL_IN = 0, WL_PA = 10752 * 1024, WL_PB = WL_PA + 512 * 1024, WL_PC = WL_PB + 1024 * 1024, WL_MIX = WL_PC + 512 * 1024,
                 WL_XQ = WL_MIX + 2 * MiB, WL_XKV = WL_XQ + 1 * MiB, WL_XO = WL_XKV + 2 * MiB, WL_SIZE = WL_XO + 1 * MiB;
static_assert(WL_SIZE == 18944 * 1024, "layer weight block");
constexpr size_t WS_FFN_GU = WS_W + 2 * WL_SIZE;
constexpr size_t WS_FFN_DN = WS_FFN_GU + 11 * MiB;
constexpr size_t WS_MOE_GU = 58 * MiB;
constexpr size_t WS_XN8 = 114 * MiB;
constexpr size_t WL_IN_G8 = 4608 * 1024;
constexpr size_t WS_MOE_DN = 170 * MiB;
constexpr size_t WS_MEMN = 226 * MiB;
constexpr size_t WS_KX = 230 * MiB;
constexpr size_t WS_VTX = 232 * MiB;
constexpr size_t WS_XN = 236 * MiB;
constexpr size_t WS_HEADS = 268 * MiB;
constexpr size_t HD_QA = 0, HD_KA = 8 * MiB, HD_VTA = 16 * MiB, HD_QB = 24 * MiB, HD_KB = 40 * MiB, HD_VTB = 44 * MiB, HD_QC = 48 * MiB, HD_KC = 56 * MiB, HD_VTC = 64 * MiB;
constexpr size_t WS_G = 340 * MiB;
constexpr size_t WS_QX = WS_G, WS_OX = WS_G + 16 * MiB;
constexpr size_t WS_O = 436 * MiB;
constexpr int O_A = 0, O_B = 256, O_C = 768;
constexpr size_t WS_UBF = WS_XN;
constexpr size_t WS_XRES = 468 * MiB;
constexpr int HFFN_LD = DFF + 64;
constexpr size_t WS_HFFN = WS_HEADS;
constexpr size_t WS_HMOE = WS_HEADS;
constexpr size_t WS_Y = 396 * MiB;
constexpr size_t WS_END = 500 * MiB;
static_assert( WS_HMOE + (size_t)73 * 256 * DFE * 2 <= WS_Y && WS_Y + (size_t)34816 * D * 2 <= WS_XRES && WS_HFFN + (size_t)M * HFFN_LD * 2 <= WS_OX + 16 * MiB && WS_FFN_DN + (size_t)D * HFFN_LD * 2 <= WS_MOE_GU, "ws map");
constexpr int MOE_MAX_RT = 136, MOE_CHUNK_RT = 64, MOE_X = 9;

constexpr int RING_BYTES = 131072, LDS_BYTES = 147456, MISC_OFF = LDS_BYTES - 256;
constexpr int NWAVES = 8;

#define XB_TMO      128
#define XB_XCNT(j)  (256  + 64 * (j))
#define XB_XSUB(j)  (1280 + 64 * (j))
#define XB_XGEN(j)  (2304 + 64 * (j))
#define XB_TOP      3328
#define XB_TOPGEN   3392
#define XCD_BAR_WORDS 3456
#define XB_SPIN_CAP (1u << 18)
__device__ __forceinline__ unsigned xb_ld(unsigned* p)              { return __hip_atomic_load(p, __ATOMIC_RELAXED, __HIP_MEMORY_SCOPE_AGENT); }
__device__ __forceinline__ unsigned xb_add(unsigned* p, unsigned v) { return __hip_atomic_fetch_add(p, v, __ATOMIC_RELAXED, __HIP_MEMORY_SCOPE_AGENT); }
__device__ __forceinline__ unsigned xb_xcc_id() { return (unsigned)__builtin_amdgcn_s_getreg((3 << 11) | 20) & 0xFu; }
#define XB_SPIN(cond, bar) do { unsigned _sp = 0; while (cond) { __builtin_amdgcn_s_sleep(1); \
    if ((++_sp & 255u) == 0u) { if (xb_ld(&(bar)[XB_TMO])) break; if (_sp > XB_SPIN_CAP) { atomicAdd(&(bar)[XB_TMO], 1u); break; } } } } while (0)
struct XcdBarrier { unsigned* bar; unsigned x; volatile LAS unsigned* st; };
__device__ __forceinline__ XcdBarrier xcd_barrier_post(unsigned* bar, volatile LAS unsigned* st, int tid) {
    XcdBarrier b; b.bar = bar; b.x = xb_xcc_id(); b.st = st;
    if (tid == 0) (void)xb_add(&bar[XB_XCNT(b.x)], 1u);
    return b;
}
__device__ __forceinline__ void xcd_barrier_complete(unsigned* bar, unsigned x, unsigned& nloc, unsigned& nx) {
    const unsigned G = gridDim.x * gridDim.y * gridDim.z;
    unsigned sum, cnt, mine, sp = 0u;
    for (;;) {
        sum = 0u; cnt = 0u; mine = 0u;
#pragma unroll
        for (unsigned j = 0; j < 16; ++j) { const unsigned c = xb_ld(&bar[XB_XCNT(j)]); sum += c; cnt += (c > 0u) ? 1u : 0u; mine = (j == x) ? c : mine; }
        if (sum == G) break;
        __builtin_amdgcn_s_sleep(1);
        if ((++sp & 255u) == 0u) { if (xb_ld(&bar[XB_TMO])) break; if (sp > XB_SPIN_CAP) { atomicAdd(&bar[XB_TMO], 1u); break; } }
    }
    nloc = mine > 0u ? mine : 1u; nx = cnt > 0u ? cnt : 1u;
}
__device__ __forceinline__ void xcd_barrier(const XcdBarrier& b, int tid  ) {
    asm volatile("s_waitcnt vmcnt(0)" ::: "memory");
    __syncthreads();
    if (tid == 0) {
        unsigned* bar = b.bar;
        __builtin_amdgcn_s_waitcnt(0);
        unsigned nloc = b.st[0], nx = b.st[1];
        if (nloc == 0u) { xcd_barrier_complete(bar, b.x, nloc, nx); b.st[0] = nloc; b.st[1] = nx; }
        const unsigned old = xb_add(&bar[XB_XSUB(b.x)], 1u);
        const unsigned gen = old / nloc;
        if (old + 1u == (gen + 1u) * nloc) {
            __builtin_amdgcn_fence(__ATOMIC_RELEASE, "agent");
            asm volatile("s_waitcnt vmcnt(0)" ::: "memory");
            const unsigned og = xb_add(&bar[XB_TOP], 1u);
            const unsigned tg = og / nx;
            if (og + 1u == (tg + 1u) * nx) xb_add(&bar[XB_TOPGEN], 1u);
            else XB_SPIN(xb_ld(&bar[XB_TOPGEN]) == tg, bar);
            __builtin_amdgcn_fence(__ATOMIC_ACQUIRE, "agent");
            xb_add(&bar[XB_XGEN(b.x)], 1u);
            asm volatile("s_waitcnt vmcnt(0)" ::: "memory");
        } else {
            XB_SPIN(xb_ld(&bar[XB_XGEN(b.x)]) == gen, bar);
            __builtin_amdgcn_fence(__ATOMIC_ACQUIRE, "agent");
            asm volatile("s_waitcnt vmcnt(0)" ::: "memory");
        }
    }
    __syncthreads();
}

using pg8::Unit;
__device__ __forceinline__ int pi32c(int r) { return (r & ~12) | ((r & 4) << 1) | ((r & 8) >> 1); }
template <bool I8> __device__ __forceinline__ f32x4 acc_val(const f32x4& a, const f32x4& cs, float rsv) {
    if constexpr (I8) return (f32x4){(float)__float_as_int(a[0]), (float)__float_as_int(a[1]), (float)__float_as_int(a[2]), (float)__float_as_int(a[3])} * (cs * rsv); else return a; }
template <bool I8> struct EpiInprojT {
    static constexpr bool PERM = true, HAS_MID = false;
    unsigned char* ws; const float* ropec; const float* ropes; LAS unsigned char* ldsx;
    const float* rs = nullptr; const unsigned* cmax = nullptr;
    __device__ __forceinline__ void operator()(const f32x4 (&acc)[2][2][4][2], const Unit& u, int wr, int wc, int fr, int fq) const {
        const int row0 = u.po * 256 + wr * 64 + fr;
        const int pn = u.pn;
        f32x4 cs[2][2];
#pragma unroll
        for (int bj = 0; bj < 2; ++bj)
#pragma unroll
            for (int n = 0; n < 2; ++n) { if constexpr (I8) { const u32x4 c4 = *(const u32x4*)(cmax + pn * 256 + bj * 128 + wc * 32 + 8 * fq + 4 * n);
                cs[bj][n] = (f32x4){__uint_as_float(c4.x), __uint_as_float(c4.y), __uint_as_float(c4.z), __uint_as_float(c4.w)} * (1.0f / 127.0f); } else cs[bj][n] = (f32x4){1.f, 1.f, 1.f, 1.f}; }
        float rsr[2][4];
#pragma unroll
        for (int ai = 0; ai < 2; ++ai)
#pragma unroll
            for (int m = 0; m < 4; ++m) rsr[ai][m] = I8 ? rs[row0 + ai * 128 + m * 16] : 1.f;
        if (pn >= 9) {
            bf16* G = (bf16*)(ws + WS_G);
            const int col0 = (pn - 9) * 256 + wc * 32 + 8 * fq;
            for (int rp = 0; rp < REPS(19); ++rp) { asm volatile("" ::: "memory");
#pragma unroll
            for (int ai = 0; ai < 2; ++ai)
#pragma unroll
                for (int m = 0; m < 4; ++m) { bf16* rowp = G + (size_t)(row0 + ai * 128 + m * 16) * 3072 + col0; const float rsv = rsr[ai][m];
#pragma unroll
                    for (int bj = 0; bj < 2; ++bj) { const f32x4 v0 = acc_val<I8>(acc[ai][bj][m][0], cs[bj][0], rsv), v1 = acc_val<I8>(acc[ai][bj][m][1], cs[bj][1], rsv); u32x4 w;
                        w.x = cvt_pk_bf16(sigmoidf_fast(v0[0]), sigmoidf_fast(v0[1])); w.y = cvt_pk_bf16(sigmoidf_fast(v0[2]), sigmoidf_fast(v0[3]));
                        w.z = cvt_pk_bf16(sigmoidf_fast(v1[0]), sigmoidf_fast(v1[1])); w.w = cvt_pk_bf16(sigmoidf_fast(v1[2]), sigmoidf_fast(v1[3]));
                        st16(rowp + bj * 128, w); } } }
            return;
        }
        int kind = 0  , H = 4, head = wc; bool rope = false; float sc = 1.f; size_t off = 0;
        switch (pn) {
            case 0: off = HD_QA; rope = true; sc = QSCALE64; break;
            case 1: off = HD_KA; rope = true; break;
            case 2: off = HD_VTA; kind = 1; break;
            case 3: off = HD_QB; H = 8; rope = true; sc = QSCALE64; break;
            case 4: off = HD_QB; H = 8; head = 4 + wc; rope = true; sc = QSCALE64; break;
            case 5: H = 2; if (wc < 2) { off = HD_KB; rope = true; } else { off = HD_VTB; kind = 1; head = wc - 2; } break;
            case 6: off = HD_QC; sc = QSCALE64; break;
            case 7: off = HD_KC; break;
            default: off = HD_VTC; kind = 1; break;
        }
        bf16* base = (bf16*)(ws + WS_HEADS + off);
        const int b = (u.po * 256) / T;
        const int tb = (u.po * 256) % T + wr * 64 + fr;
        if (kind == 0) { for (int rp = 0; rp < REPS(18); ++rp) { asm volatile("" ::: "memory");
            bf16* hb = base + ((size_t)(b * H + head) * T) * 64 + 8 * fq;
            const bool isk = (pn == 1) || (pn == 5) || (pn == 7);
            bf16* kbase = base + ((size_t)(b * H + head) * T) * 64;
            f32x4 rcb[1][4];
#define EI_LDROPE(buf, tt) do { rcb[buf][0] = *(const f32x4*)(ropec + (tt) * 32 + 8 * fq); rcb[buf][1] = *(const f32x4*)(ropec + (tt) * 32 + 8 * fq + 4); rcb[buf][2] = *(const f32x4*)(ropes + (tt) * 32 + 8 * fq); rcb[buf][3] = *(const f32x4*)(ropes + (tt) * 32 + 8 * fq + 4); } while (0)
            EI_LDROPE(0, tb);
#pragma unroll
            for (int it = 0; it < 8; ++it) { const int ai = it >> 2, m = it & 3; const int t = tb + ai * 128 + m * 16; const float rsv = rsr[ai][m];
                    f32x4 x1a = acc_val<I8>(acc[ai][0][m][0], cs[0][0], rsv), x1b = acc_val<I8>(acc[ai][0][m][1], cs[0][1], rsv), x2a = acc_val<I8>(acc[ai][1][m][0], cs[1][0], rsv), x2b = acc_val<I8>(acc[ai][1][m][1], cs[1][1], rsv);
                    if (rope) { const f32x4 ca = rcb[0][0], cb = rcb[0][1];
                        const f32x4 sa = rcb[0][2], sb = rcb[0][3];
                        const f32x4 y1a = x1a * ca - x2a * sa, y2a = x2a * ca + x1a * sa, y1b = x1b * cb - x2b * sb, y2b = x2b * cb + x1b * sb;
                        x1a = y1a; x2a = y2a; x1b = y1b; x2b = y2b; }
                    asm volatile("" ::: "memory");
                    if (it + 1 < 8) EI_LDROPE(0, tb + ((it + 1) >> 2) * 128 + ((it + 1) & 3) * 16);
                    x1a = x1a * sc; x1b = x1b * sc; x2a = x2a * sc; x2b = x2b * sc;
                    u32x4 w1, w2; w1.x = cvt_pk_bf16(x1a[0], x1a[1]); w1.y = cvt_pk_bf16(x1a[2], x1a[3]); w1.z = cvt_pk_bf16(x1b[0], x1b[1]); w1.w = cvt_pk_bf16(x1b[2], x1b[3]);
                    w2.x = cvt_pk_bf16(x2a[0], x2a[1]); w2.y = cvt_pk_bf16(x2a[2], x2a[3]); w2.z = cvt_pk_bf16(x2b[0], x2b[1]); w2.w = cvt_pk_bf16(x2b[2], x2b[3]);
                    if (isk) { bf16* kp = kbase + ((size_t)(t >> 5) * 8 + (fq & 1)) * 256 + (size_t)pi32c(t & 31) * 8 + (size_t)(fq >> 1) * 512;
                        st16(kp, w1); st16(kp + 1024, w2); }
                    else { bf16* rp = hb + (size_t)t * 64; st16(rp, w1); st16(rp + 32, w2); } }
#undef EI_LDROPE
        } } else { for (int rp = 0; rp < REPS(20); ++rp) { asm volatile("" ::: "memory");
            bf16* vb2 = base + (size_t)(b * H + head) * 64 * T;
            LAS bf16* tr = (LAS bf16*)(ldsx + (wr * 4 + wc) * 1024);
            const int ln = fq * 16 + fr, dd = ln >> 1, th = ln & 1;
#pragma unroll
            for (int ai = 0; ai < 2; ++ai)
#pragma unroll
                for (int m = 0; m < 4; ++m) { const int t16 = (u.po * 256) % T + wr * 64 + ai * 128 + m * 16;
                    const float rsv = rsr[ai][m];
#pragma unroll
                    for (int bj = 0; bj < 2; ++bj) {
#pragma unroll
                        for (int n = 0; n < 2; ++n) { const f32x4 av = acc_val<I8>(acc[ai][bj][m][n], cs[bj][n], rsv);
#pragma unroll
                            for (int e = 0; e < 4; e += 2) { const unsigned w = cvt_pk_bf16(av[e], av[e + 1]);
                                tr[(8 * fq + 4 * n + e) * 16 + fr] = (bf16)(w & 0xffffu); tr[(8 * fq + 4 * n + e + 1) * 16 + fr] = (bf16)(w >> 16); } }
                        const u32x4 v = *(const LAS u32x4*)(tr + dd * 16 + 8 * th);
                        const int t8 = t16 + 8 * th;
                        *(u32x4*)(vb2 + ((size_t)(((t8 >> 5) * 2 + bj) * 4 + ((t8 >> 3) & 3)) * 32 + dd) * 8) = v; } }
        } }
    }
};
using EpiInproj = EpiInprojT<false>;
struct EpiGates8 {
    static constexpr bool PERM = true, HAS_MID = false;
    unsigned char* ws;
    __device__ __forceinline__ void operator()(const f32x4 (&acc)[2][2][4][2], const Unit& u, int wr, int wc, int fr, int fq) const {
        bf16* G = (bf16*)(ws + WS_G);
        const int row0 = u.po * 256 + wr * 64 + fr, col0 = u.pn * 256 + wc * 32 + 8 * fq;
#pragma unroll
        for (int ai = 0; ai < 2; ++ai)
#pragma unroll
            for (int m = 0; m < 4; ++m) { bf16* rowp = G + (size_t)(row0 + ai * 128 + m * 16) * 3072 + col0;
#pragma unroll
                for (int bj = 0; bj < 2; ++bj) { const f32x4 v0 = acc[ai][bj][m][0] * F8_WINV, v1 = acc[ai][bj][m][1] * F8_WINV; u32x4 w;
                    w.x = cvt_pk_bf16(sigmoidf_fast(v0[0]), sigmoidf_fast(v0[1])); w.y = cvt_pk_bf16(sigmoidf_fast(v0[2]), sigmoidf_fast(v0[3]));
                    w.z = cvt_pk_bf16(sigmoidf_fast(v1[0]), sigmoidf_fast(v1[1])); w.w = cvt_pk_bf16(sigmoidf_fast(v1[2]), sigmoidf_fast(v1[3]));
                    st16(rowp + bj * 128, w); } }
    }
};
struct GateOrder {
    pg8::StaticOrder so; int nskip;
    __device__ void init(int G_, int c_, int nskip_) { so.init(M, 3072, G_, c_); nskip = nskip_; }
    __device__ __forceinline__ bool next(int i, Unit& u) const {
        long L; const int r = (so.c < nskip) ? i + 2 : i;
        if (r < 2) L = (long)r * (so.G - nskip) + (so.c - nskip); else L = 2L * (so.G - nskip) + (long)(r - 2) * so.G + so.c;
        int pm, pn; if (!so.next_L(L, pm, pn)) return false; u.pm = pm; u.pn = pn; u.pb = pn; u.po = pm; return true; }
};
struct EpiKvMem {
    static constexpr bool PERM = true, HAS_MID = false;
    unsigned char* ws;
    __device__ __forceinline__ void operator()(const f32x4 (&acc)[2][2][4][2], const Unit& u, int wr, int wc, int fr, int fq) const {
        const int lb = u.po;
        const int pn = u.pn & 3;
        const int j0 = wr * 64 + fr;
        if (pn < 2) {
            bf16* kx = (bf16*)(ws + WS_KX);
#pragma unroll
            for (int ai = 0; ai < 2; ++ai)
#pragma unroll
                for (int m = 0; m < 4; ++m) { const int j = j0 + ai * 128 + m * 16;
#pragma unroll
                    for (int bj = 0; bj < 2; ++bj) { const int head = 2 * pn + bj, d = wc * 32 + 8 * fq; const f32x4 v0 = acc[ai][bj][m][0], v1 = acc[ai][bj][m][1]; u32x4 w;
                        w.x = cvt_pk_bf16(v0[0], v0[1]); w.y = cvt_pk_bf16(v0[2], v0[3]); w.z = cvt_pk_bf16(v1[0], v1[1]); w.w = cvt_pk_bf16(v1[2], v1[3]);
                        *(u32x4*)(kx + (size_t)(lb * 4 + head) * 256 * 128 + ((size_t)((j >> 5) * 8 + (d >> 4)) * 2 + ((d >> 3) & 1)) * 256 + (size_t)pi32c(j & 31) * 8) = w; } }
        } else {
            bf16* vx = (bf16*)(ws + WS_VTX);
#pragma unroll
            for (int ai = 0; ai < 2; ++ai)
#pragma unroll
                for (int m = 0; m < 4; ++m) { const int j = j0 + ai * 128 + m * 16;
#pragma unroll
                    for (int bj = 0; bj < 2; ++bj) { const int head = 2 * (pn - 2) + bj;
#pragma unroll
                        for (int n = 0; n < 2; ++n)
#pragma unroll
                            for (int e = 0; e < 4; e += 2) { const int d = wc * 32 + 8 * fq + 4 * n + e; const unsigned w = cvt_pk_bf16(acc[ai][bj][m][n][e], acc[ai][bj][m][n][e + 1]);
                                bf16* p = vx + (size_t)(lb * 4 + head) * 128 * 256 + ((size_t)(((j >> 5) * 4 + (d >> 5)) * 4 + ((j >> 3) & 3)) * 32 + (d & 31)) * 8 + (j & 7); p[0] = (bf16)(w & 0xffffu); p[8] = (bf16)(w >> 16); } } }
        }
    }
};
struct EpiGateMix {
    static constexpr bool PERM = false, HAS_MID = true;
    const bf16* G; bf16* UBF;
    __device__ __forceinline__ bool is_mid(int t) const { return t == 4 || t == 12; }
    __device__ __forceinline__ void mid(f32x4 (&acc)[2][2][4][2], const Unit& u, int t, int wr, int wc, int fr, int fq) const {
        const int row0 = u.po * 256 + wr * 64 + fr, col0 = u.pn * 256 + wc * 32 + 4 * fq + (t == 4 ? 0 : 1024);
#pragma unroll
        for (int ai = 0; ai < 2; ++ai)
#pragma unroll
            for (int m = 0; m < 4; ++m) { const bf16* gr = G + (size_t)(row0 + ai * 128 + m * 16) * 3072 + col0;
#pragma unroll
                for (int bj = 0; bj < 2; ++bj)
#pragma unroll
                    for (int n = 0; n < 2; ++n) { const u32x2 gn = *(const u32x2*)(gr + bj * 128 + n * 16), gd = *(const u32x2*)(gr + bj * 128 + n * 16 + 1024);
                        f32x4 v = acc[ai][bj][m][n];
                        v[0] *= bflo(gn.x) * fast_rcp(fmaxf(bflo(gd.x), 1e-6f)); v[1] *= bfhi(gn.x) * fast_rcp(fmaxf(bfhi(gd.x), 1e-6f));
                        v[2] *= bflo(gn.y) * fast_rcp(fmaxf(bflo(gd.y), 1e-6f)); v[3] *= bfhi(gn.y) * fast_rcp(fmaxf(bfhi(gd.y), 1e-6f));
                        acc[ai][bj][m][n] = v; } }
    }
    __device__ __forceinline__ void operator()(const f32x4 (&acc)[2][2][4][2], const Unit& u, int wr, int wc, int fr, int fq) const {
        const int row0 = u.po * 256 + wr * 64 + fr, col0 = u.pn * 256 + wc * 32 + 4 * fq;
#pragma unroll
        for (int aim = 0; aim < 4; ++aim) { const int ai = aim >> 1;
            u32x2 gwb[4][2][2];
#pragma unroll
            for (int m = 2 * (aim & 1); m < 2 * (aim & 1) + 2; ++m)
#pragma unroll
                for (int bj = 0; bj < 2; ++bj)
#pragma unroll
                    for (int n = 0; n < 2; ++n) gwb[m][bj][n] = *(const u32x2*)(G + (size_t)(row0 + ai * 128 + m * 16) * 3072 + 2048 + col0 + bj * 128 + n * 16);
#pragma unroll
            for (int m = 2 * (aim & 1); m < 2 * (aim & 1) + 2; ++m) { const size_t r = (size_t)(row0 + ai * 128 + m * 16);
#pragma unroll
                for (int bj = 0; bj < 2; ++bj)
#pragma unroll
                    for (int n = 0; n < 2; ++n) { const int c = col0 + bj * 128 + n * 16; const u32x2 gw = gwb[m][bj][n];
                        const f32x4 v = acc[ai][bj][m][n]; u32x2 w;
                        w.x = cvt_pk_bf16(v[0] * fmaxf(bflo(gw.x), 1e-6f), v[1] * fmaxf(bfhi(gw.x), 1e-6f)); w.y = cvt_pk_bf16(v[2] * fmaxf(bflo(gw.y), 1e-6f), v[3] * fmaxf(bfhi(gw.y), 1e-6f));
                        st8(UBF + r * D + c, w); } } }
    }
};
template <bool FIRST> struct EpiResid {
    static constexpr bool PERM = true, HAS_MID = false;
    const float* x0; const bf16* XR; bf16* XO;
    __device__ __forceinline__ void operator()(const f32x4 (&acc)[2][2][4][2], const Unit& u, int wr, int wc, int fr, int fq) const {
        const int row0 = u.po * 256 + wr * 64 + fr, col0 = u.pn * 256 + wc * 32 + 8 * fq;
#pragma unroll
        for (int ai = 0; ai < 2; ++ai) {
            f32x4 pre[4][2][2];
#pragma unroll
            for (int m = 0; m < 4; ++m) { const size_t r = (size_t)(row0 + ai * 128 + m * 16) * D + col0;
#pragma unroll
                for (int bj = 0; bj < 2; ++bj) {
                    if (FIRST) { pre[m][bj][0] = *(const f32x4*)(x0 + r + bj * 128); pre[m][bj][1] = *(const f32x4*)(x0 + r + bj * 128 + 4); }
                    else { const u32x4 w = *(const u32x4*)(XR + r + bj * 128); pre[m][bj][0] = (f32x4){bflo(w.x), bfhi(w.x), bflo(w.y), bfhi(w.y)}; pre[m][bj][1] = (f32x4){bflo(w.z), bfhi(w.z), bflo(w.w), bfhi(w.w)}; } } }
#pragma unroll
            for (int m = 0; m < 4; ++m) { const size_t r = (size_t)(row0 + ai * 128 + m * 16) * D + col0;
#pragma unroll
                for (int bj = 0; bj < 2; ++bj) { const f32x4 v0 = pre[m][bj][0] + acc[ai][bj][m][0], v1 = pre[m][bj][1] + acc[ai][bj][m][1]; u32x4 w;
                    w.x = cvt_pk_bf16(v0[0], v0[1]); w.y = cvt_pk_bf16(v0[2], v0[3]); w.z = cvt_pk_bf16(v1[0], v1[1]); w.w = cvt_pk_bf16(v1[2], v1[3]);
                    st16(XO + r + bj * 128, w); } }
        }
    }
};
struct EpiXq {
    static constexpr bool PERM = true, HAS_MID = false;
    bf16* QX; float osc;
    __device__ __forceinline__ void operator()(const f32x4 (&acc)[2][2][4][2], const Unit& u, int wr, int wc, int fr, int fq) const {
        const int b = (u.po * 256) / T, tb = (u.po * 256) % T + wr * 64 + fr;
#pragma unroll
        for (int ai = 0; ai < 2; ++ai)
#pragma unroll
            for (int m = 0; m < 4; ++m) { const int t = tb + ai * 128 + m * 16; const float rn = osc;
#pragma unroll
                for (int bj = 0; bj < 2; ++bj) { const int head = 2 * u.pn + bj; const f32x4 v0 = acc[ai][bj][m][0] * rn, v1 = acc[ai][bj][m][1] * rn; u32x4 w;
                    w.x = cvt_pk_bf16(v0[0], v0[1]); w.y = cvt_pk_bf16(v0[2], v0[3]); w.z = cvt_pk_bf16(v1[0], v1[1]); w.w = cvt_pk_bf16(v1[2], v1[3]);
                    st16(QX + ((size_t)(b * 4 + head) * T + t) * 128 + wc * 32 + 8 * fq, w); } }
    }
};
struct EpiSwiglu {
    static constexpr bool PERM = true, HAS_MID = false;
    bf16* Hd; int ldh;
    __device__ __forceinline__ void operator()(const f32x4 (&acc)[2][2][4][2], const Unit& u, int wr, int wc, int fr, int fq) const {
        const int row0 = u.po * 256 + wr * 64 + fr, col0 = u.pn * 128 + wc * 32 + 8 * fq;
#pragma unroll
        for (int ai = 0; ai < 2; ++ai)
#pragma unroll
            for (int m = 0; m < 4; ++m) { float h[8];
#pragma unroll
                for (int n = 0; n < 2; ++n)
#pragma unroll
                    for (int e = 0; e < 4; ++e) { const float gt = acc[ai][0][m][n][e], up = acc[ai][1][m][n][e]; h[4 * n + e] = gt * sigmoidf_fast(gt) * up; }
                u32x4 w; w.x = cvt_pk_bf16(h[0], h[1]); w.y = cvt_pk_bf16(h[2], h[3]); w.z = cvt_pk_bf16(h[4], h[5]); w.w = cvt_pk_bf16(h[6], h[7]);
                st16(Hd + (size_t)(row0 + ai * 128 + m * 16) * ldh + col0, w); }
    }
};
struct EpiSwigluI8 {
    static constexpr bool PERM = true, HAS_MID = false;
    bf16* Hd; int ldh; const float* rs; const unsigned* cmax;
    __device__ __forceinline__ void operator()(const f32x4 (&acc)[2][2][4][2], const Unit& u, int wr, int wc, int fr, int fq) const {
        const int row0 = u.po * 256 + wr * 64 + fr, col0 = u.pn * 128 + wc * 32 + 8 * fq;
        float cg[8], cu[8];
        { const unsigned* cp = cmax + u.pn * 256 + wc * 32 + 8 * fq; const u32x4 g0 = *(const u32x4*)cp, g1 = *(const u32x4*)(cp + 4), u0 = *(const u32x4*)(cp + 128), u1 = *(const u32x4*)(cp + 132);
#pragma unroll
          for (int e = 0; e < 4; ++e) { cg[e] = __uint_as_float(g0[e]) * (1.0f / 127.0f); cg[4 + e] = __uint_as_float(g1[e]) * (1.0f / 127.0f); cu[e] = __uint_as_float(u0[e]) * (1.0f / 127.0f); cu[4 + e] = __uint_as_float(u1[e]) * (1.0f / 127.0f); } }
        float rsr[2][4];
#pragma unroll
        for (int ai = 0; ai < 2; ++ai)
#pragma unroll
            for (int m = 0; m < 4; ++m) rsr[ai][m] = rs[row0 + ai * 128 + m * 16];
#pragma unroll
        for (int ai = 0; ai < 2; ++ai)
#pragma unroll
            for (int m = 0; m < 4; ++m) { float h[8]; const float rsv = rsr[ai][m];
#pragma unroll
                for (int n = 0; n < 2; ++n)
#pragma unroll
                    for (int e = 0; e < 4; ++e) { const float gt = (float)__float_as_int(acc[ai][0][m][n][e]) * (rsv * cg[4 * n + e]), up = (float)__float_as_int(acc[ai][1][m][n][e]) * (rsv * cu[4 * n + e]); h[4 * n + e] = gt * sigmoidf_fast(gt) * up; }
                u32x4 w; w.x = cvt_pk_bf16(h[0], h[1]); w.y = cvt_pk_bf16(h[2], h[3]); w.z = cvt_pk_bf16(h[4], h[5]); w.w = cvt_pk_bf16(h[6], h[7]);
                st16(Hd + (size_t)(row0 + ai * 128 + m * 16) * ldh + col0, w); }
    }
};
struct EpiSwiglu8 {
    static constexpr bool PERM = true, HAS_MID = false;
    unsigned char* Hd; int ldh;
    __device__ __forceinline__ void operator()(const f32x4 (&acc)[2][2][4][2], const Unit& u, int wr, int wc, int fr, int fq) const {
        const int row0 = u.po * 256 + wr * 64 + fr, col0 = u.pn * 128 + wc * 32 + 8 * fq;
#pragma unroll
        for (int ai = 0; ai < 2; ++ai)
#pragma unroll
            for (int m = 0; m < 4; ++m) { float h[8];
#pragma unroll
                for (int n = 0; n < 2; ++n)
#pragma unroll
                    for (int e = 0; e < 4; ++e) { const float gt = acc[ai][0][m][n][e] * F8_WINV, up = acc[ai][1][m][n][e] * F8_WINV; h[4 * n + e] = gt * sigmoidf_fast(gt) * up; }
                u32x2 w; w.x = cvt_pk4_fp8(h[0], h[1], h[2], h[3]); w.y = cvt_pk4_fp8(h[4], h[5], h[6], h[7]);
                st8(Hd + (size_t)(row0 + ai * 128 + m * 16) * ldh + col0, w); }
    }
};
struct EpiBf16Out {
    static constexpr bool PERM = true, HAS_MID = false;
    bf16* O; int ldc; float sc;
    __device__ __forceinline__ void operator()(const f32x4 (&acc)[2][2][4][2], const Unit& u, int wr, int wc, int fr, int fq) const {
        const int row0 = u.po * 256 + wr * 64 + fr, col0 = u.pn * 256 + wc * 32 + 8 * fq;
#pragma unroll
        for (int ai = 0; ai < 2; ++ai)
#pragma unroll
            for (int m = 0; m < 4; ++m) { bf16* rowp = O + (size_t)(row0 + ai * 128 + m * 16) * ldc + col0;
#pragma unroll
                for (int bj = 0; bj < 2; ++bj) { const f32x4 v0 = acc[ai][bj][m][0] * sc, v1 = acc[ai][bj][m][1] * sc; u32x4 w;
                    w.x = cvt_pk_bf16(v0[0], v0[1]); w.y = cvt_pk_bf16(v0[2], v0[3]); w.z = cvt_pk_bf16(v1[0], v1[1]); w.w = cvt_pk_bf16(v1[2], v1[3]);
                    st16(rowp + bj * 128, w); } }
    }
};
struct Frame {
    LAS unsigned char* lds;
    int tid, lane, wave, G;
    unsigned char* ws;
};
__device__ __forceinline__ float wave_sum(float v) {
#pragma unroll
    for (int o = 1; o < 64; o <<= 1) v += __shfl_xor(v, o);
    return v;
}
#define LDS_WAIT() asm volatile("s_waitcnt lgkmcnt(0)" ::: "memory")
__device__ __forceinline__ Frame phase_frame(const Frame& F0) {
    Frame F = F0; int w = F0.wave; asm volatile("" : "+s"(w)); F.wave = w;
    int ln; asm volatile("v_mbcnt_lo_u32_b32 %0, -1, 0\n\tv_mbcnt_hi_u32_b32 %0, -1, %0" : "=&v"(ln));
    F.lane = ln; F.tid = w * 64 + ln;
    int g = F0.G; asm volatile("" : "+s"(g)); F.G = g; unsigned char* p = F0.ws; asm volatile("" : "+s"(p)); F.ws = p; return F; }

__device__ __forceinline__ float wave_max(float v) {
#pragma unroll
    for (int o = 1; o < 64; o <<= 1) v = fmaxf(v, __shfl_xor(v, o));
    return v;
}
__device__ __forceinline__ unsigned pack4_i8(float a, float b, float c, float d) { return ((unsigned)(int)rintf(a) & 255u) | (((unsigned)(int)rintf(b) & 255u) << 8) | (((unsigned)(int)rintf(c) & 255u) << 16) | ((unsigned)(int)rintf(d) << 24); }
template <int OUT8 = 0> __device__ __forceinline__ void transpose_item(const float* W, int ld, int col0, int k0, bf16* WT, int pitch, int row0, LAS float* scr, int lane, const unsigned* cmax = nullptr) {
    f32x4 wv[8];
#pragma unroll
    for (int i = 0; i < 8; ++i) wv[i] = *(const f32x4*)(W + (size_t)(k0 + 8 * i + (lane >> 3)) * ld + col0 + 4 * (lane & 7));
#pragma unroll
    for (int i = 0; i < 8; ++i) { LAS float* d = scr + (8 * i + (lane >> 3)) * 33 + 4 * (lane & 7); d[0] = wv[i][0]; d[1] = wv[i][1]; d[2] = wv[i][2]; d[3] = wv[i][3]; }
    LDS_WAIT(); asm volatile("" ::: "memory");
    const int c = lane & 7;
#pragma unroll
    for (int j = 0; j < 4; ++j) { const int n = (lane >> 3) + 8 * j; const LAS float* s = scr + (8 * c) * 33 + n;
        if constexpr (OUT8 == 2) { const float cm = __uint_as_float(cmax[row0 + n]), sc = cm > 0.f ? 127.0f / cm : 0.f;
            u32x2 o; o.x = pack4_i8(s[0 * 33] * sc, s[1 * 33] * sc, s[2 * 33] * sc, s[3 * 33] * sc); o.y = pack4_i8(s[4 * 33] * sc, s[5 * 33] * sc, s[6 * 33] * sc, s[7 * 33] * sc);
            st8((unsigned char*)WT + (size_t)(row0 + n) * pitch + k0 + 8 * c, o); continue; }
        if constexpr (OUT8 == 1) {
            u32x2 o; o.x = cvt_pk4_fp8(s[0 * 33] * F8_WSCALE, s[1 * 33] * F8_WSCALE, s[2 * 33] * F8_WSCALE, s[3 * 33] * F8_WSCALE); o.y = cvt_pk4_fp8(s[4 * 33] * F8_WSCALE, s[5 * 33] * F8_WSCALE, s[6 * 33] * F8_WSCALE, s[7 * 33] * F8_WSCALE);
            st8((unsigned char*)WT + (size_t)(row0 + n) * pitch + k0 + 8 * c, o); continue; }
        u32x4 o; o.x = cvt_pk_bf16(s[0 * 33], s[1 * 33]); o.y = cvt_pk_bf16(s[2 * 33], s[3 * 33]); o.z = cvt_pk_bf16(s[4 * 33], s[5 * 33]); o.w = cvt_pk_bf16(s[6 * 33], s[7 * 33]);
        st16(WT + (size_t)(row0 + n) * pitch + k0 + 8 * c, o); }
    LDS_WAIT(); asm volatile("" ::: "memory");
}
template <int MAP, int OUT8 = 0> __device__ __forceinline__ void transpose_matrix(const Frame& F, int& rot, const float* W, const float* W2, int ld, int K, int Nv, bf16* WT, LAS float* scr, int pitch = 0, const unsigned* cmax = nullptr) {
    if (pitch == 0) pitch = K;
    const int NGW = F.G * NWAVES; int gw = blockIdx.x * NWAVES + F.wave - rot; if (gw < 0) gw += NGW;
    const int ngrp = Nv / 32, nitems = (K / 64) * ngrp;
    rot = (rot + nitems) % NGW;
    for (int it = gw; it < nitems; it += NGW) {
        const int kb = it / ngrp, g = it % ngrp; const float* src = W; int col0 = 32 * g;
        if (MAP == 1) { if (g < 72) { const int tile = g >> 3, q = g & 7; col0 = 256 * tile + 64 * (q & 3) + 32 * (q >> 2); } }
        if (MAP == 2) { const int tile = g >> 3, q = g & 7; if (q < 4) { col0 = 128 * tile + 32 * q; } else { src = W2; col0 = 128 * tile + 32 * (q - 4); } }
        transpose_item<OUT8>(src, ld, col0, 64 * kb, WT, pitch, 32 * g, scr, F.lane, cmax);
    }
}
template <int MAP> __device__ __forceinline__ void f8_item(const float* W, const float* W2, int ld, int ngrp, int it, unsigned char* WT, int pitch, LAS float* scr, int lane) {
    const int kb = it / ngrp, g = it % ngrp; const float* src = W; int col0 = 32 * g;
    if (MAP == 2) { const int tile = g >> 3, q = g & 7; if (q < 4) { col0 = 128 * tile + 32 * q; } else { src = W2; col0 = 128 * tile + 32 * (q - 4); } }
    const int k0 = 128 * kb;
    f32x4 wv[16];
#pragma unroll
    for (int i = 0; i < 16; ++i) wv[i] = *(const f32x4*)(src + (size_t)(k0 + 8 * i + (lane >> 3)) * ld + col0 + 4 * (lane & 7));
#pragma unroll
    for (int i = 0; i < 16; ++i) { const int kk = 8 * i + (lane >> 3); LAS float* d = scr + kk * 33 + ((4 * (lane & 7) + 8 * (kk >> 4)) & 31); d[0] = wv[i][0]; d[1] = wv[i][1]; d[2] = wv[i][2]; d[3] = wv[i][3]; }
    LDS_WAIT(); asm volatile("" ::: "memory");
    const int c = lane & 7;
#pragma unroll
    for (int j = 0; j < 4; ++j) { const int n = (lane >> 3) + 8 * j; const LAS float* s = scr + (16 * c) * 33 + ((n + 8 * c) & 31);
        u32x4 o; o.x = cvt_pk4_fp8(s[0 * 33] * F8_WSCALE, s[1 * 33] * F8_WSCALE, s[2 * 33] * F8_WSCALE, s[3 * 33] * F8_WSCALE); o.y = cvt_pk4_fp8(s[4 * 33] * F8_WSCALE, s[5 * 33] * F8_WSCALE, s[6 * 33] * F8_WSCALE, s[7 * 33] * F8_WSCALE);
        o.z = cvt_pk4_fp8(s[8 * 33] * F8_WSCALE, s[9 * 33] * F8_WSCALE, s[10 * 33] * F8_WSCALE, s[11 * 33] * F8_WSCALE); o.w = cvt_pk4_fp8(s[12 * 33] * F8_WSCALE, s[13 * 33] * F8_WSCALE, s[14 * 33] * F8_WSCALE, s[15 * 33] * F8_WSCALE);
        st16(WT + (size_t)(32 * g + n) * pitch + k0 + 16 * c, o); }
    LDS_WAIT(); asm volatile("" ::: "memory");
}
constexpr int MOE_ITEMS_GU = (D / 128) * (2 * DFE / 32), MOE_ITEMS_DN = (DFE / 128) * (D / 32), MOE_ITEMS_E = MOE_ITEMS_GU + MOE_ITEMS_DN, MOE_ITEMS = NE * MOE_ITEMS_E;
#ifndef MOE_TAIL_A0
#define MOE_TAIL_A0 0
#define MOE_TAIL_A6 3
#define MOE_TAIL_A10 2
#endif
constexpr int MOE_TAIL_B6 = 160 * NWAVES * MOE_TAIL_A0, MOE_TAIL_B10 = MOE_TAIL_B6 + 128 * NWAVES * MOE_TAIL_A6, MOE_TAIL_ITEMS = MOE_TAIL_B10 + 128 * NWAVES * MOE_TAIL_A10;
static_assert(MOE_TAIL_ITEMS <= MOE_ITEMS, "tail shares");
__device__ __forceinline__ void moe_conv_item(int q, const float* mg, const float* mu, const float* md, unsigned char* ws, LAS float* scr, int lane) {
    const int e = q / MOE_ITEMS_E, r = q % MOE_ITEMS_E;
    if (r < MOE_ITEMS_GU) f8_item<2>(mg + (size_t)e * D * DFE, mu + (size_t)e * D * DFE, DFE, 2 * DFE / 32, r, ws + WS_MOE_GU + (size_t)e * 2 * DFE * D, D, scr, lane);
    else f8_item<0>(md + (size_t)e * DFE * D, nullptr, D, D / 32, r - MOE_ITEMS_GU, ws + WS_MOE_DN + (size_t)e * D * DFE, DFE, scr, lane);
}
__device__ __forceinline__ void moe_conv_tail(const Frame& F, int base, int rank, int n, const float* mg, const float* mu, const float* md) {
    LAS float* scr = (LAS float*)(F.lds + F.wave * 16896);
    for (int j = 0; j < n; ++j) moe_conv_item(base + (rank * NWAVES + F.wave) * n + j, mg, mu, md, F.ws, scr, F.lane);
}
template <int MAP> __device__ __forceinline__ void colmax_matrix(const Frame& F, int& rot, const float* W, const float* W2, int ld, int K, int Nv, unsigned* cmax) {
    const int NGW = F.G * NWAVES; int gw = blockIdx.x * NWAVES + F.wave - rot; if (gw < 0) gw += NGW;
    const int ngrp = Nv / 32, nitems = (K / 64) * ngrp;
    rot = (rot + nitems) % NGW;
    const int lane = F.lane;
    for (int it = gw; it < nitems; it += NGW) {
        const int kb = it / ngrp, g = it % ngrp; const float* src = W; int col0 = 32 * g;
        if (MAP == 1) { if (g < 72) { const int tile = g >> 3, q = g & 7; col0 = 256 * tile + 64 * (q & 3) + 32 * (q >> 2); } }
        if (MAP == 2) { const int tile = g >> 3, q = g & 7; if (q < 4) { col0 = 128 * tile + 32 * q; } else { src = W2; col0 = 128 * tile + 32 * (q - 4); } }
        f32x4 mx = {0.f, 0.f, 0.f, 0.f};
#pragma unroll
        for (int i = 0; i < 8; ++i) { const f32x4 w = *(const f32x4*)(src + (size_t)(64 * kb + 8 * i + (lane >> 3)) * ld + col0 + 4 * (lane & 7));
#pragma unroll
            for (int e = 0; e < 4; ++e) mx[e] = fmaxf(mx[e], fabsf(w[e])); }
#pragma unroll
        for (int e = 0; e < 4; ++e) { mx[e] = fmaxf(mx[e], __shfl_xor(mx[e], 8)); mx[e] = fmaxf(mx[e], __shfl_xor(mx[e], 16)); mx[e] = fmaxf(mx[e], __shfl_xor(mx[e], 32)); }
        if (lane < 8) {
#pragma unroll
            for (int e = 0; e < 4; ++e) atomicMax(cmax + 32 * g + 4 * lane + e, __float_as_uint(mx[e])); }
    }
}
template <bool ROUTER, bool SRCBF = true, bool WRITE = true, int OUT8 = 0  , bool ALSO8 = false> __device__ __forceinline__ void norm_rows(const Frame& F, const void* src, const float* gain, bf16* dst, int rows, const float* wrouter, int* tok_e, float* tok_w, float* rtok = nullptr, unsigned char* dst8 = nullptr, float* rscale = nullptr) {
    const int gw = blockIdx.x * NWAVES + F.wave, NGW = F.G * NWAVES;
    f32x4 gv[4];
#pragma unroll
    for (int j = 0; j < 4; ++j) gv[j] = *(const f32x4*)(gain + 4 * F.lane + 256 * j);
    constexpr int NRB = 4;
    for (int m0 = gw; m0 < rows; m0 += NRB * NGW) {
      u32x2 rawb[NRB][4]; f32x4 rawf[NRB][4];
#pragma unroll
      for (int i = 0; i < NRB; ++i) { const int mi = m0 + i * NGW, m = mi < rows ? mi : rows - 1;
#pragma unroll
          for (int j = 0; j < 4; ++j) { if (SRCBF) rawb[i][j] = ((const u32x2*)((const bf16*)src + (size_t)m * D) + F.lane)[64 * j]; else rawf[i][j] = ((const f32x4*)((const float*)src + (size_t)m * D) + F.lane)[64 * j]; } }
#pragma unroll
      for (int i = 0; i < NRB; ++i) { const int m = m0 + i * NGW; if (m >= rows) break;
        f32x4 v[4]; float s = 0.f;
#pragma unroll
        for (int j = 0; j < 4; ++j) {
            if (SRCBF) { const u32x2 w = rawb[i][j]; v[j] = (f32x4){bflo(w.x), bfhi(w.x), bflo(w.y), bfhi(w.y)}; }
            else v[j] = rawf[i][j];
            s += (v[j][0] * v[j][0] + v[j][1] * v[j][1]) + (v[j][2] * v[j][2] + v[j][3] * v[j][3]); }
        const float r = 1.0f / sqrtf(wave_sum(s) * (1.0f / D) + EPS);
        u32x2* o8 = (u32x2*)(dst + (size_t)m * D) + F.lane;
        if constexpr (OUT8 == 2) { float am = 0.f;
#pragma unroll
            for (int j = 0; j < 4; ++j) { v[j] = v[j] * r * gv[j]; am = fmaxf(fmaxf(am, fmaxf(fabsf(v[j][0]), fabsf(v[j][1]))), fmaxf(fabsf(v[j][2]), fabsf(v[j][3]))); }
            am = wave_max(am); const float inv = am > 0.f ? 127.0f / am : 0.f;
#pragma unroll
            for (int j = 0; j < 4; ++j) ((unsigned*)((unsigned char*)dst + (size_t)m * D) + F.lane)[64 * j] = pack4_i8(v[j][0] * inv, v[j][1] * inv, v[j][2] * inv, v[j][3] * inv);
            if (F.lane == 0) rscale[m] = am * (1.0f / 127.0f);
            continue; }
#pragma unroll
        for (int j = 0; j < 4; ++j) { v[j] = v[j] * r * gv[j]; if (ALSO8) ((unsigned*)(dst8 + (size_t)m * D) + F.lane)[64 * j] = cvt_pk4_fp8(v[j][0], v[j][1], v[j][2], v[j][3]);
            if (WRITE && OUT8 == 1) { ((unsigned*)((unsigned char*)dst + (size_t)m * D) + F.lane)[64 * j] = cvt_pk4_fp8(v[j][0], v[j][1], v[j][2], v[j][3]); } else if (WRITE) { u32x2 w; w.x = cvt_pk_bf16(v[j][0], v[j][1]); w.y = cvt_pk_bf16(v[j][2], v[j][3]); st8(o8 + 64 * j, w); } }
        if (ROUTER) {
            float lg[8];
#pragma unroll
            for (int e = 0; e < 8; ++e) lg[e] = 0.f;
#pragma unroll
            for (int j = 0; j < 4; ++j)
#pragma unroll
                for (int c = 0; c < 4; ++c) { const float* wp = wrouter + (size_t)(4 * F.lane + 256 * j + c) * 8; const f32x4 w0 = *(const f32x4*)wp, w1 = *(const f32x4*)(wp + 4); const float hv = v[j][c];
                    lg[0] = fmaf(hv, w0[0], lg[0]); lg[1] = fmaf(hv, w0[1], lg[1]); lg[2] = fmaf(hv, w0[2], lg[2]); lg[3] = fmaf(hv, w0[3], lg[3]);
                    lg[4] = fmaf(hv, w1[0], lg[4]); lg[5] = fmaf(hv, w1[1], lg[5]); lg[6] = fmaf(hv, w1[2], lg[6]); lg[7] = fmaf(hv, w1[3], lg[7]); }
#pragma unroll
            for (int e = 0; e < 8; ++e) lg[e] = wave_sum(lg[e]);
            if (F.lane == 0) {
                int i1 = 0; float v1 = lg[0];
#pragma unroll
                for (int e = 1; e < 8; ++e) if (lg[e] > v1) { v1 = lg[e]; i1 = e; }
                int i2 = 0; float v2 = -INFINITY;
#pragma unroll
                for (int e = 0; e < 8; ++e) if (e != i1 && lg[e] > v2) { v2 = lg[e]; i2 = e; }
                const float e2 = expf(v2 - v1); const float w1 = 1.0f / (1.0f + e2);
                tok_e[2 * m] = i1; tok_e[2 * m + 1] = i2; tok_w[2 * m] = w1; tok_w[2 * m + 1] = e2 * w1; if (rtok) rtok[m] = r;
            }
        }
      }
    }
}
__device__ __forceinline__ void moe_route(const Frame& F, const int* tok_e, int* tok_slot, int* rowmap, int* meta) {
    LAS int* cnt = (LAS int*)F.lds;
    LAS int* tot = cnt + 8 * 512;
    const int t0 = F.tid * 32;
    int c[8];
#pragma unroll
    for (int e = 0; e < 8; ++e) c[e] = 0;
    for (int i = 0; i < 64; ++i) { const int e = tok_e[2 * t0 + i];
#pragma unroll
        for (int k = 0; k < 8; ++k) c[k] += (e == k) ? 1 : 0; }
#pragma unroll
    for (int e = 0; e < 8; ++e) cnt[e * 512 + F.tid] = c[e];
    __syncthreads();
    {
        const int e = F.wave; int v[8]; int s = 0;
#pragma unroll
        for (int k = 0; k < 8; ++k) { v[k] = cnt[e * 512 + F.lane * 8 + k]; s += v[k]; }
        int incl = s;
#pragma unroll
        for (int o = 1; o < 64; o <<= 1) { const int y = __shfl_up(incl, o); if (F.lane >= o) incl += y; }
        int run = incl - s;
#pragma unroll
        for (int k = 0; k < 8; ++k) { cnt[e * 512 + F.lane * 8 + k] = run; run += v[k]; }
        if (F.lane == 63) tot[e] = incl;
    }
    __syncthreads();
    if (F.tid == 0) { int base = 0, rt = 0;
        for (int e = 0; e < 8; ++e) { const int n = tot[e], nt = (n + 255) >> 8; tot[8 + e] = base;
            for (int k = 0; k < nt; ++k) meta[16 + rt + k] = e;
            rt += nt; base += nt * 256; }
        meta[0] = rt; }
    __syncthreads();
    for (int e = 0; e < 8; ++e) { const int n = tot[e], base = tot[8 + e], end = base + (((n + 255) >> 8) << 8);
        for (int s = base + n + F.tid; s < end; s += 512) rowmap[s] = 0; }
    int run[8];
#pragma unroll
    for (int e = 0; e < 8; ++e) run[e] = tot[8 + e] + cnt[e * 512 + F.tid];
    for (int i = 0; i < 64; ++i) { const int e = tok_e[2 * t0 + i]; int slot = 0;
#pragma unroll
        for (int k = 0; k < 8; ++k) if (e == k) { slot = run[k]; run[k] += 1; }
        tok_slot[2 * t0 + i] = slot; rowmap[slot] = t0 + (i >> 1); }
    __syncthreads();
}
__device__ __forceinline__ void combine_final(const Frame& F, const bf16* x, const bf16* Y, const int* tok_slot, const float* tok_w, const float* gain, float* out) {
    const int gw = blockIdx.x * NWAVES + F.wave, NGW = F.G * NWAVES;
    f32x4 gv[4];
#pragma unroll
    for (int j = 0; j < 4; ++j) gv[j] = *(const f32x4*)(gain + 4 * F.lane + 256 * j);
    constexpr int NRB = 4;
    for (int m0 = gw; m0 < M; m0 += NRB * NGW) {
      int s1v[NRB], s2v[NRB]; float w1v[NRB], w2v[NRB];
#pragma unroll
      for (int i = 0; i < NRB; ++i) { const int mi = m0 + i * NGW, m = mi < M ? mi : M - 1; const u32x2 sl = *(const u32x2*)(tok_slot + 2 * m); const f32x2 tw = *(const f32x2*)(tok_w + 2 * m); s1v[i] = (int)sl.x; s2v[i] = (int)sl.y; w1v[i] = tw[0]; w2v[i] = tw[1]; }
      u32x2 rx[NRB][4], ra[NRB][4], rb[NRB][4];
#pragma unroll
      for (int i = 0; i < NRB; ++i) { const int mi = m0 + i * NGW, m = mi < M ? mi : M - 1;
        const u32x2* xr = (const u32x2*)(x + (size_t)m * D) + F.lane; const u32x2* y1 = (const u32x2*)(Y + (size_t)s1v[i] * D) + F.lane; const u32x2* y2 = (const u32x2*)(Y + (size_t)s2v[i] * D) + F.lane;
#pragma unroll
        for (int j = 0; j < 4; ++j) { rx[i][j] = xr[64 * j]; ra[i][j] = y1[64 * j]; rb[i][j] = y2[64 * j]; } }
#pragma unroll
      for (int i = 0; i < NRB; ++i) { const int m = m0 + i * NGW; if (m >= M) break; const float w1 = w1v[i], w2 = w2v[i];
        f32x4 v[4]; float s = 0.f;
#pragma unroll
        for (int j = 0; j < 4; ++j) { const u32x2 xw = rx[i][j]; v[j] = (f32x4){bflo(xw.x), bfhi(xw.x), bflo(xw.y), bfhi(xw.y)}; const u32x2 a = ra[i][j], b = rb[i][j];
            v[j][0] += w1 * bflo(a.x) + w2 * bflo(b.x); v[j][1] += w1 * bfhi(a.x) + w2 * bfhi(b.x); v[j][2] += w1 * bflo(a.y) + w2 * bflo(b.y); v[j][3] += w1 * bfhi(a.y) + w2 * bfhi(b.y);
            s += (v[j][0] * v[j][0] + v[j][1] * v[j][1]) + (v[j][2] * v[j][2] + v[j][3] * v[j][3]); }
        const float r = 1.0f / sqrtf(wave_sum(s) * (1.0f / D) + EPS);
        f32x4* o = (f32x4*)(out + (size_t)m * D) + F.lane;
#pragma unroll
        for (int j = 0; j < 4; ++j) o[64 * j] = v[j] * r * gv[j];
      }
    }
}

__device__ __forceinline__ int pi32(int r) { return (r & ~12) | ((r & 4) << 1) | ((r & 8) >> 1); }
#define MFMA32(a, b, c) __builtin_amdgcn_mfma_f32_32x32x16_bf16((a), (b), (c), 0, 0, 0)
template <int ND0> __device__ __forceinline__ f32x16 qk_tile(const bf16* Kh, int key0, const bf16x8* qr, int r32, int hi) {
    const bf16* kp = Kh + (size_t)(key0 >> 5) * (ND0 * 512) + (size_t)(hi * 32 + r32) * 8;
    f32x16 s = {0.f, 0.f, 0.f, 0.f, 0.f, 0.f, 0.f, 0.f, 0.f, 0.f, 0.f, 0.f, 0.f, 0.f, 0.f, 0.f};
#pragma unroll
    for (int d0 = 0; d0 < ND0; ++d0) { const bf16x8 kf = *(const GAS bf16x8*)(kp + d0 * 512); s = MFMA32(kf, qr[d0], s); }
    return s;
}
template <int NDT> __device__ __forceinline__ void pv_tile(const bf16* Vt, int, int key0, bf16x8 p0, bf16x8 p1, f32x16* o, int r32, int hi) {
    const bf16* vp = Vt + (size_t)(key0 >> 5) * (NDT * 1024) + (size_t)(hi * 32 + r32) * 8;
#pragma unroll
    for (int dt = 0; dt < NDT; ++dt) { const bf16x8 v0 = *(const GAS bf16x8*)(vp + dt * 1024), v1 = *(const GAS bf16x8*)(vp + dt * 1024 + 512);
        o[dt] = MFMA32(v0, p0, o[dt]); o[dt] = MFMA32(v1, p1, o[dt]); }
}
__device__ __forceinline__ bf16x8 pack8(const f32x16& p, int b) {
    u32x4 w; w.x = cvt_pk_bf16(p[b], p[b + 1]); w.y = cvt_pk_bf16(p[b + 2], p[b + 3]); w.z = cvt_pk_bf16(p[b + 4], p[b + 5]); w.w = cvt_pk_bf16(p[b + 6], p[b + 7]);
    return __builtin_bit_cast(bf16x8, w);
}
__device__ __forceinline__ float xhalf_max(float v) { auto rr = __builtin_amdgcn_permlane32_swap(__float_as_uint(v), __float_as_uint(v), false, false); return fmaxf(__uint_as_float(rr[0]), __uint_as_float(rr[1])); }
__device__ __forceinline__ float xhalf_sum(float v) { auto rr = __builtin_amdgcn_permlane32_swap(__float_as_uint(v), __float_as_uint(v), false, false); return __uint_as_float(rr[0]) + __uint_as_float(rr[1]); }
template <int NDT> __device__ __forceinline__ void softmax_step(f32x16& s, float& m, float& l, f32x16* o, bf16x8& p0, bf16x8& p1) {
    float tm = fmaxf(fmaxf(s[0], s[1]), fmaxf(s[2], s[3]));
#pragma unroll
    for (int r = 4; r < 16; r += 4) tm = fmaxf(tm, fmaxf(fmaxf(s[r], s[r + 1]), fmaxf(s[r + 2], s[r + 3])));
    tm = xhalf_max(tm);
    const float mn = fmaxf(m, tm), al = fast_exp2(m - mn); m = mn;
    float ps = 0.f;
#pragma unroll
    for (int r = 0; r < 16; ++r) { s[r] = fast_exp2(s[r] - mn); ps += s[r]; }
    l = l * al + ps;
#pragma unroll
    for (int dt = 0; dt < NDT; ++dt)
#pragma unroll
        for (int r = 0; r < 16; ++r) o[dt][r] *= al;
    p0 = pack8(s, 0); p1 = pack8(s, 8);
}
template <int NDT> __device__ __forceinline__ void store_o(bf16* Orow  , const f32x16* o, float scale, int hi) {
#pragma unroll
    for (int dt = 0; dt < NDT; ++dt)
#pragma unroll
        for (int g = 0; g < 4; ++g) { u32x2 w; w.x = cvt_pk_bf16(o[dt][4 * g] * scale, o[dt][4 * g + 1] * scale); w.y = cvt_pk_bf16(o[dt][4 * g + 2] * scale, o[dt][4 * g + 3] * scale);
            st8(Orow + dt * 32 + 8 * g + 4 * hi, w); }
}
template <int ND0> __device__ __forceinline__ void load_q(bf16x8* qr, const bf16* Qh  , int t0, int r32, int hi) {
#pragma unroll
    for (int d0 = 0; d0 < ND0; ++d0) qr[d0] = *(const GAS bf16x8*)(Qh + (size_t)(t0 + r32) * (16 * ND0) + d0 * 16 + hi * 8);
}
#define KEY_OF(r, hi) (16 * ((r) >> 3) + 8 * (hi) + ((r) & 7))

template <int ND0> __device__ __forceinline__ void load_k(bf16x8* kf, const bf16* Kh, int key0, int r32, int hi) {
    const bf16* kp = Kh + (size_t)(key0 >> 5) * (ND0 * 512) + (size_t)(hi * 32 + r32) * 8;
#pragma unroll
    for (int d0 = 0; d0 < ND0; ++d0) kf[d0] = *(const GAS bf16x8*)(kp + d0 * 512);
}
template <int NDT> __device__ __forceinline__ void load_v(bf16x8* vf, const bf16* Vt, int  , int key0, int r32, int hi) {
    const bf16* vp = Vt + (size_t)(key0 >> 5) * (NDT * 1024) + (size_t)(hi * 32 + r32) * 8;
#pragma unroll
    for (int dt = 0; dt < NDT; ++dt) { vf[2 * dt] = *(const GAS bf16x8*)(vp + dt * 1024); vf[2 * dt + 1] = *(const GAS bf16x8*)(vp + dt * 1024 + 512); }
}
template <int MK> __device__ __forceinline__ void apply_mask(f32x16& s, int r32, int hi) {
    if (MK == 1) {
#pragma unroll
        for (int r = 0; r < 16; ++r) if (KEY_OF(r, hi) > r32) s[r] = -INFINITY; }
    if (MK == 2) {
#pragma unroll
        for (int r = 0; r < 16; ++r) if (KEY_OF(r, hi) <= r32) s[r] = -INFINITY; }
}
__device__ __forceinline__ float max16(const f32x16& s) {
    float a = fmaxf(fmaxf(s[0], s[1]), fmaxf(s[2], s[3]));
#pragma unroll
    for (int r = 4; r < 16; r += 4) a = fmaxf(a, fmaxf(fmaxf(s[r], s[r + 1]), fmaxf(s[r + 2], s[r + 3])));
    return a;
}
template <int ND0, int NDT, bool HAS2, int MA, int MB>
__device__ __forceinline__ void flash_compute(const bf16x8* kfa, const bf16x8* kfb, const bf16x8* va, const bf16x8* vb, const bf16x8* qr, float lane_inf, float& m, float& l, f32x16* o, int r32, int hi);
template <int ND0, int NDT, bool HAS2, int MA, int MB>
__device__ __forceinline__ void flash_step(const bf16x8* kfa, const bf16x8* kfb, const bf16* Vt, int ldv, int key0a, int key0b, const bf16x8* qr, float lane_inf,
                                           float& m, float& l, f32x16* o, int r32, int hi) {
    bf16x8 va[2 * NDT], vb[2 * NDT];
    load_v<NDT>(va, Vt, ldv, key0a, r32, hi);
    if (HAS2) load_v<NDT>(vb, Vt, ldv, key0b, r32, hi);
    flash_compute<ND0, NDT, HAS2, MA, MB>(kfa, kfb, va, vb, qr, lane_inf, m, l, o, r32, hi);
}
template <int ND0, int NDT, bool HAS2, int MA, int MB>
__device__ __forceinline__ void flash_compute(const bf16x8* kfa, const bf16x8* kfb, const bf16x8* va, const bf16x8* vb, const bf16x8* qr, float lane_inf, float& m, float& l, f32x16* o, int r32, int hi) {
    f32x16 sa = {0.f, 0.f, 0.f, 0.f, 0.f, 0.f, 0.f, 0.f, 0.f, 0.f, 0.f, 0.f, 0.f, 0.f, 0.f, 0.f}, sb = sa;
#pragma unroll
    for (int d0 = 0; d0 < ND0; ++d0) { sa = MFMA32(kfa[d0], qr[d0], sa); if (HAS2) sb = MFMA32(kfb[d0], qr[d0], sb); }
    apply_mask<MA>(sa, r32, hi); if (HAS2) apply_mask<MB>(sb, r32, hi);
    float tm = max16(sa); if (HAS2) tm = fmaxf(tm, max16(sb));
    tm = xhalf_max(tm) - lane_inf;
    if (__builtin_amdgcn_ballot_w64(tm > m) != 0ull) {
        const float mn = fmaxf(m, tm), al = fast_exp2(m - mn); m = mn; l *= al;
#pragma unroll
        for (int dt = 0; dt < NDT; ++dt)
#pragma unroll
            for (int r = 0; r < 16; ++r) o[dt][r] *= al;
    }
    const float ms = m + lane_inf;
    float ps = 0.f;
#pragma unroll
    for (int r = 0; r < 16; ++r) { sa[r] = fast_exp2(sa[r] - ms); ps += sa[r]; }
    if (HAS2) {
#pragma unroll
        for (int r = 0; r < 16; ++r) { sb[r] = fast_exp2(sb[r] - ms); ps += sb[r]; } }
    l += ps;
    const bf16x8 pa0 = pack8(sa, 0), pa1 = pack8(sa, 8);
#pragma unroll
    for (int dt = 0; dt < NDT; ++dt) { o[dt] = MFMA32(va[2 * dt], pa0, o[dt]); o[dt] = MFMA32(va[2 * dt + 1], pa1, o[dt]); }
    if (HAS2) { const bf16x8 pb0 = pack8(sb, 0), pb1 = pack8(sb, 8);
#pragma unroll
        for (int dt = 0; dt < NDT; ++dt) { o[dt] = MFMA32(vb[2 * dt], pb0, o[dt]); o[dt] = MFMA32(vb[2 * dt + 1], pb1, o[dt]); } }
}
#define COPY_K(dst, src, N) do { _Pragma("unroll") for (int _d = 0; _d < (N); ++_d) dst[_d] = src[_d]; } while (0)

__device__ __forceinline__ void moba_item(const Frame& F, int b, int h, int qt, const float* kmean) {
    const int lane = F.lane, r32 = lane & 31, hi = lane >> 5, r32p = pi32(r32);
    const bf16* Qh = (const bf16*)(F.ws + WS_HEADS + HD_QA) + (size_t)(b * 4 + h) * T * 64;
    const bf16* Kh = (const bf16*)(F.ws + WS_HEADS + HD_KA) + (size_t)(b * 4 + h) * T * 64;
    const bf16* Vt = (const bf16*)(F.ws + WS_HEADS + HD_VTA) + (size_t)(b * 4 + h) * 64 * T;
    const int t0 = qt * 32, own = t0 >> 8;
    bf16x8 qr[4]; load_q<4>(qr, Qh, t0, r32, hi);
    bf16x8 kfa[4], kfb[4], kna[4], knb[4];
    const int NT = qt + 1;
    load_k<4>(kfa, Kh, 0, r32, hi); if (NT > 1) load_k<4>(kfb, Kh, 32, r32, hi);
    unsigned selmask = 0u;
    if (own > 0) {
        float sc[16];
        const float* km = kmean + (size_t)(b * 4 + h) * 16 * 64 + hi * 8;
        float qf[32];
#pragma unroll
        for (int d0 = 0; d0 < 4; ++d0) { const u32x4 w = __builtin_bit_cast(u32x4, qr[d0]); qf[8 * d0 + 0] = bflo(w.x); qf[8 * d0 + 1] = bfhi(w.x); qf[8 * d0 + 2] = bflo(w.y); qf[8 * d0 + 3] = bfhi(w.y);
            qf[8 * d0 + 4] = bflo(w.z); qf[8 * d0 + 5] = bfhi(w.z); qf[8 * d0 + 6] = bflo(w.w); qf[8 * d0 + 7] = bfhi(w.w); }
#pragma unroll
        for (int j = 0; j < 15; ++j) { float a = 0.f;
            if (j < own) {
#pragma unroll
                for (int d0 = 0; d0 < 4; ++d0) { const f32x4 k0 = *(const f32x4*)(km + j * 64 + d0 * 16), k1 = *(const f32x4*)(km + j * 64 + d0 * 16 + 4);
                    a = fmaf(qf[8 * d0 + 0], k0[0], a); a = fmaf(qf[8 * d0 + 1], k0[1], a); a = fmaf(qf[8 * d0 + 2], k0[2], a); a = fmaf(qf[8 * d0 + 3], k0[3], a);
                    a = fmaf(qf[8 * d0 + 4], k1[0], a); a = fmaf(qf[8 * d0 + 5], k1[1], a); a = fmaf(qf[8 * d0 + 6], k1[2], a); a = fmaf(qf[8 * d0 + 7], k1[3], a); }
                a = xhalf_sum(a);
            } else a = -INFINITY;
            sc[j] = a; }
        sc[15] = -INFINITY;
        const int nsel = own < 3 ? own : 3;
#pragma unroll
        for (int r = 0; r < 3; ++r) if (r < nsel) { int bi = 0; float bv = -INFINITY;
#pragma unroll
            for (int j = 0; j < 15; ++j) if (sc[j] > bv) { bv = sc[j]; bi = j; }
            selmask |= 1u << bi;
#pragma unroll
            for (int j = 0; j < 15; ++j) if (j == bi) sc[j] = -INFINITY; }
    }
    selmask |= 1u << own;
    float m = -1e30f, l = 0.f; f32x16 o[2];
#pragma unroll
    for (int dt = 0; dt < 2; ++dt)
#pragma unroll
        for (int r = 0; r < 16; ++r) o[dt][r] = 0.f;
    const int nfull = (NT - 1) >> 1;
    for (int s = 0; s < nfull; ++s) {
        const int key0 = 64 * s;
        if (2 * s + 2 < NT) load_k<4>(kna, Kh, key0 + 64, r32, hi);
        if (2 * s + 3 < NT) load_k<4>(knb, Kh, key0 + 96, r32, hi);
        const float lane_inf = ((selmask >> (s >> 2)) & 1u) ? 0.f : INFINITY;
        flash_step<4, 2, true, 0, 0>(kfa, kfb, Vt, T, key0, key0 + 32, qr, lane_inf, m, l, o, r32, hi);
        COPY_K(kfa, kna, 4); COPY_K(kfb, knb, 4);
    }
    if (NT & 1) flash_step<4, 2, false, 1, 0>(kfa, kfb, Vt, T, 64 * nfull, 0, qr, 0.f, m, l, o, r32, hi);
    else        flash_step<4, 2, true, 0, 1>(kfa, kfb, Vt, T, 64 * nfull, 64 * nfull + 32, qr, 0.f, m, l, o, r32, hi);
    l = xhalf_sum(l);
    bf16* Orow = (bf16*)(F.ws + WS_O) + (size_t)(b * T + t0 + r32) * D + O_A + h * 64;
    store_o<2>(Orow, o, fast_rcp(l), hi);
}
__device__ __forceinline__ void moba_wg(const Frame& F, int b, int h, int qt, int S_total, const float* kmean) {
    const int lane = F.lane, r32 = lane & 31, hi = lane >> 5;
    const bf16* Qh = (const bf16*)(F.ws + WS_HEADS + HD_QA) + (size_t)(b * 4 + h) * T * 64;
    const unsigned char* Kg = F.ws + WS_HEADS + HD_KA + (size_t)(b * 4 + h) * T * 64 * 2;
    const unsigned char* Vg = F.ws + WS_HEADS + HD_VTA + (size_t)(b * 4 + h) * 64 * T * 2;
    LAS unsigned char* ring = F.lds;
#define MW_ISSUE(s) do { const int _sc = (s) < S_total ? (s) : S_total - 1; \
        __builtin_amdgcn_global_load_lds((const unsigned*)(Kg + (size_t)_sc * 8192 + F.wave * 1024 + lane * 16), (LAS unsigned*)(ring + ((s) & 3) * 16384 + F.wave * 1024), 16, 0, 0); \
        __builtin_amdgcn_global_load_lds((const unsigned*)(Vg + (size_t)_sc * 8192 + F.wave * 1024 + lane * 16), (LAS unsigned*)(ring + ((s) & 3) * 16384 + 8192 + F.wave * 1024), 16, 0, 0); } while (0)
    const int t0 = qt * 32, own = t0 >> 8;
    bf16x8 qr[4]; load_q<4>(qr, Qh, t0, r32, hi);
    const int NT = qt + 1;
    unsigned selmask = 0u;
    if (own > 0) {
        float sc[16];
        const float* km = kmean + (size_t)(b * 4 + h) * 16 * 64 + hi * 8;
        float qf[32];
#pragma unroll
        for (int d0 = 0; d0 < 4; ++d0) { const u32x4 w = __builtin_bit_cast(u32x4, qr[d0]); qf[8 * d0 + 0] = bflo(w.x); qf[8 * d0 + 1] = bfhi(w.x); qf[8 * d0 + 2] = bflo(w.y); qf[8 * d0 + 3] = bfhi(w.y);
            qf[8 * d0 + 4] = bflo(w.z); qf[8 * d0 + 5] = bfhi(w.z); qf[8 * d0 + 6] = bflo(w.w); qf[8 * d0 + 7] = bfhi(w.w); }
#pragma unroll
        for (int j = 0; j < 15; ++j) { float a = 0.f;
            if (j < own) {
#pragma unroll
                for (int d0 = 0; d0 < 4; ++d0) { const f32x4 k0 = *(const f32x4*)(km + j * 64 + d0 * 16), k1 = *(const f32x4*)(km + j * 64 + d0 * 16 + 4);
                    a = fmaf(qf[8 * d0 + 0], k0[0], a); a = fmaf(qf[8 * d0 + 1], k0[1], a); a = fmaf(qf[8 * d0 + 2], k0[2], a); a = fmaf(qf[8 * d0 + 3], k0[3], a);
                    a = fmaf(qf[8 * d0 + 4], k1[0], a); a = fmaf(qf[8 * d0 + 5], k1[1], a); a = fmaf(qf[8 * d0 + 6], k1[2], a); a = fmaf(qf[8 * d0 + 7], k1[3], a); }
                a = xhalf_sum(a);
            } else a = -INFINITY;
            sc[j] = a; }
        sc[15] = -INFINITY;
        const int nsel = own < 3 ? own : 3;
#pragma unroll
        for (int r = 0; r < 3; ++r) if (r < nsel) { int bi = 0; float bv = -INFINITY;
#pragma unroll
            for (int j = 0; j < 15; ++j) if (sc[j] > bv) { bv = sc[j]; bi = j; }
            selmask |= 1u << bi;
#pragma unroll
            for (int j = 0; j < 15; ++j) if (j == bi) sc[j] = -INFINITY; }
    }
    selmask |= 1u << own;
    asm volatile("s_waitcnt vmcnt(0)" ::: "memory");
    MW_ISSUE(0); MW_ISSUE(1); MW_ISSUE(2);
    float m = -1e30f, l = 0.f; f32x16 o[2];
#pragma unroll
    for (int dt = 0; dt < 2; ++dt)
#pragma unroll
        for (int r = 0; r < 16; ++r) o[dt][r] = 0.f;
    const int nfull = (NT - 1) >> 1;
    for (int s = 0; s < S_total; ++s) {
        asm volatile("s_waitcnt vmcnt(4)" ::: "memory");
        __builtin_amdgcn_s_barrier();
        MW_ISSUE(s + 3);
        if (s <= nfull) {
            const LAS bf16* Kl = (const LAS bf16*)(ring + (s & 3) * 16384) + lane * 8; const LAS bf16* Vl = Kl + 4096;
            bf16x8 ka[4], kb[4], va[4], vb[4];
#pragma unroll
            for (int d0 = 0; d0 < 4; ++d0) { ka[d0] = *(const LAS bf16x8*)(Kl + d0 * 512); kb[d0] = *(const LAS bf16x8*)(Kl + 2048 + d0 * 512); }
#pragma unroll
            for (int dt = 0; dt < 2; ++dt) { va[2 * dt] = *(const LAS bf16x8*)(Vl + dt * 1024); va[2 * dt + 1] = *(const LAS bf16x8*)(Vl + dt * 1024 + 512);
                vb[2 * dt] = *(const LAS bf16x8*)(Vl + 2048 + dt * 1024); vb[2 * dt + 1] = *(const LAS bf16x8*)(Vl + 2048 + dt * 1024 + 512); }
            if (s < nfull) { const float lane_inf = ((selmask >> (s >> 2)) & 1u) ? 0.f : INFINITY; flash_compute<4, 2, true, 0, 0>(ka, kb, va, vb, qr, lane_inf, m, l, o, r32, hi); }
            else if (NT & 1) flash_compute<4, 2, false, 1, 0>(ka, kb, va, vb, qr, 0.f, m, l, o, r32, hi);
            else flash_compute<4, 2, true, 0, 1>(ka, kb, va, vb, qr, 0.f, m, l, o, r32, hi);
        }
    }
#undef MW_ISSUE
    l = xhalf_sum(l);
    bf16* Orow = (bf16*)(F.ws + WS_O) + (size_t)(b * T + t0 + r32) * D + O_A + h * 64;
    store_o<2>(Orow, o, fast_rcp(l), hi);
    asm volatile("s_waitcnt vmcnt(0)" ::: "memory");
    __syncthreads();
}
__device__ __forceinline__ void swa_item(const Frame& F, int b, int hq, int qt, const float* sinks) {
    const int lane = F.lane, r32 = lane & 31, hi = lane >> 5, r32p = pi32(r32); const int kvh = hq >> 2;
    const bf16* Qh = (const bf16*)(F.ws + WS_HEADS + HD_QB) + (size_t)(b * 8 + hq) * T * 64;
    const bf16* Kh = (const bf16*)(F.ws + WS_HEADS + HD_KB) + (size_t)(b * 2 + kvh) * T * 64;
    const bf16* Vt = (const bf16*)(F.ws + WS_HEADS + HD_VTB) + (size_t)(b * 2 + kvh) * 64 * T;
    const int t0 = qt * 32;
    bf16x8 qr[4]; load_q<4>(qr, Qh, t0, r32, hi);
    float m = -1e30f, l = 0.f; f32x16 o[2];
#pragma unroll
    for (int dt = 0; dt < 2; ++dt)
#pragma unroll
        for (int r = 0; r < 16; ++r) o[dt][r] = 0.f;
    bf16x8 k0[4], k1[4], k2[4], k3[4], k4[4];
    if (t0 >= 128) {
        load_k<4>(k0, Kh, t0 - 128, r32, hi); load_k<4>(k1, Kh, t0 - 96, r32, hi); load_k<4>(k2, Kh, t0 - 64, r32, hi); load_k<4>(k3, Kh, t0 - 32, r32, hi); load_k<4>(k4, Kh, t0, r32, hi);
        flash_step<4, 2, true, 2, 0>(k0, k1, Vt, T, t0 - 128, t0 - 96, qr, 0.f, m, l, o, r32, hi);
        flash_step<4, 2, true, 0, 0>(k2, k3, Vt, T, t0 - 64, t0 - 32, qr, 0.f, m, l, o, r32, hi);
        flash_step<4, 2, false, 1, 0>(k4, k4, Vt, T, t0, 0, qr, 0.f, m, l, o, r32, hi);
    } else {
        for (int key0 = 0; key0 < t0; key0 += 32) { load_k<4>(k0, Kh, key0, r32, hi); flash_step<4, 2, false, 0, 0>(k0, k0, Vt, T, key0, 0, qr, 0.f, m, l, o, r32, hi); }
        load_k<4>(k4, Kh, t0, r32, hi); flash_step<4, 2, false, 1, 0>(k4, k4, Vt, T, t0, 0, qr, 0.f, m, l, o, r32, hi);
    }
    l = xhalf_sum(l) + fast_exp2(sinks[hq] * LOG2E - m);
    bf16* Orow = (bf16*)(F.ws + WS_O) + (size_t)(b * T + t0 + r32) * D + O_B + hq * 64;
    store_o<2>(Orow, o, fast_rcp(l), hi);
}
__device__ __forceinline__ void sb_item(const Frame& F, int b, int h, int qt) {
    const int lane = F.lane, r32 = lane & 31, hi = lane >> 5, r32p = pi32(r32);
    const bf16* Qh = (const bf16*)(F.ws + WS_HEADS + HD_QC) + (size_t)(b * 4 + h) * T * 64;
    const bf16* Kh = (const bf16*)(F.ws + WS_HEADS + HD_KC) + (size_t)(b * 4 + h) * T * 64;
    const bf16* Vt = (const bf16*)(F.ws + WS_HEADS + HD_VTC) + (size_t)(b * 4 + h) * 64 * T;
    const int t0 = qt * 32;
    bf16x8 qr[4]; load_q<4>(qr, Qh, t0, r32, hi);
    f32x16 o[2];
#pragma unroll
    for (int dt = 0; dt < 2; ++dt)
#pragma unroll
        for (int r = 0; r < 16; ++r) o[dt][r] = 0.f;
    float carry = 1.0f;
    for (int key0 = t0; key0 >= 0; key0 -= 32) {
        f32x16 s = qk_tile<4>(Kh, key0, qr, r32, hi);
        float beta[16], keep[16];
#pragma unroll
        for (int r = 0; r < 16; ++r) { beta[r] = fast_rcp(1.0f + fast_exp2(-s[r])); }
        if (key0 == t0) {
#pragma unroll
            for (int r = 0; r < 16; ++r) if (KEY_OF(r, hi) >= r32) beta[r] = 0.f; }
#pragma unroll
        for (int r = 0; r < 16; ++r) keep[r] = 1.0f - beta[r];
        float sufA[8], sufB[8];
        sufA[7] = 1.f; sufB[7] = 1.f;
#pragma unroll
        for (int i = 6; i >= 0; --i) { sufA[i] = sufA[i + 1] * keep[i + 1]; sufB[i] = sufB[i + 1] * keep[8 + i + 1]; }
        const float PA = sufA[0] * keep[0], PB = sufB[0] * keep[8];
        auto ra = __builtin_amdgcn_permlane32_swap(__float_as_uint(PA), __float_as_uint(PA), false, false);
        auto rb = __builtin_amdgcn_permlane32_swap(__float_as_uint(PB), __float_as_uint(PB), false, false);
        const float PA_lo = __uint_as_float(ra[0]), PA_hi = __uint_as_float(ra[1]), PB_lo = __uint_as_float(rb[0]), PB_hi = __uint_as_float(rb[1]);
        const float tB = PB_lo * PB_hi;
        const float multA = carry * tB * (hi ? 1.0f : PA_hi);
        const float multB = carry * (hi ? 1.0f : PB_hi);
#pragma unroll
        for (int i = 0; i < 8; ++i) { s[i] = beta[i] * sufA[i] * multA; s[8 + i] = beta[8 + i] * sufB[i] * multB; }
        carry *= PA_lo * PA_hi * tB;
        const bf16x8 p0 = pack8(s, 0), p1 = pack8(s, 8);
        pv_tile<2>(Vt, T, key0, p0, p1, o, r32, hi);
        if (__builtin_amdgcn_ballot_w64(carry > 9.0e-13f) == 0ull) break;
    }
    bf16* Orow = (bf16*)(F.ws + WS_O) + (size_t)(b * T + t0 + r32) * D + O_C + h * 64;
    store_o<2>(Orow, o, 1.0f, hi);
}
__device__ __forceinline__ void cross_item(const Frame& F, int l, int b, int hx, int qt) {
    const int lane = F.lane, r32 = lane & 31, hi = lane >> 5, r32p = pi32(r32);
    const bf16* Qh = (const bf16*)(F.ws + WS_QX) + (size_t)(b * 4 + hx) * T * 128;
    const bf16* Kh = (const bf16*)(F.ws + WS_KX) + (size_t)((l * NB + b) * 4 + hx) * 256 * 128;
    const bf16* Vt = (const bf16*)(F.ws + WS_VTX) + (size_t)((l * NB + b) * 4 + hx) * 128 * 256;
    const int t0 = qt * 32;
    bf16x8 qr[8]; load_q<8>(qr, Qh, t0, r32, hi);
    float m = -1e30f, lsum = 0.f; f32x16 o[4];
#pragma unroll
    for (int dt = 0; dt < 4; ++dt)
#pragma unroll
        for (int r = 0; r < 16; ++r) o[dt][r] = 0.f;
    bf16x8 kfa[8], kna[8];
    load_k<8>(kfa, Kh, 0, r32, hi);
    for (int kt = 0; kt < 8; ++kt) {
        if (kt + 1 < 8) load_k<8>(kna, Kh, 32 * (kt + 1), r32, hi);
        flash_step<8, 4, false, 0, 0>(kfa, kfa, Vt, 256, 32 * kt, 0, qr, 0.f, m, lsum, o, r32, hi);
        COPY_K(kfa, kna, 8);
    }
    lsum = xhalf_sum(lsum);
    bf16* Orow = (bf16*)(F.ws + WS_OX) + (size_t)(b * T + t0 + r32) * 512 + hx * 128;
    store_o<4>(Orow, o, fast_rcp(lsum), hi);
}
__device__ __forceinline__ void kmean_phase(const Frame& F, float* kmean) {
    LAS float* part = (LAS float*)F.lds;
    for (int vb = blockIdx.x; vb < NB * 4 * 16; vb += F.G) {
        const int blk = vb & 15, bh = vb >> 4;
        const bf16* Kt = (const bf16*)(F.ws + WS_HEADS + HD_KA) + ((size_t)bh * T + blk * 256 + F.wave * 32) * 64 + (size_t)F.lane * 8;
#pragma unroll
        for (int d0 = 0; d0 < 4; ++d0) { const u32x4 w = *(const GAS u32x4*)(Kt + d0 * 512);
            float a[8] = {bflo(w.x), bfhi(w.x), bflo(w.y), bfhi(w.y), bflo(w.z), bfhi(w.z), bflo(w.w), bfhi(w.w)};
#pragma unroll
            for (int i = 0; i < 8; ++i) { a[i] += __shfl_xor(a[i], 1); a[i] += __shfl_xor(a[i], 2); a[i] += __shfl_xor(a[i], 4); a[i] += __shfl_xor(a[i], 8); a[i] += __shfl_xor(a[i], 16); }
            if ((F.lane & 31) == 0) {
#pragma unroll
                for (int i = 0; i < 8; ++i) part[F.wave * 64 + 16 * d0 + 8 * (F.lane >> 5) + i] = a[i]; } }
        __syncthreads();
        if (F.tid < 64) { float s = 0.f;
#pragma unroll
            for (int w = 0; w < 8; ++w) s += part[w * 64 + F.tid];
            kmean[(size_t)vb * 64 + F.tid] = s * (1.0f / 256.0f); }
        __syncthreads();
    }
}
#ifndef MK_PER_PHASE
#define MK_PER_PHASE 0
#endif
constexpr int CW_BAR = 4096;
constexpr int N_PHASES = 31;
struct KvOrder {
    int G, c;
    __device__ __forceinline__ bool next(int i, Unit& u) const { const int L = i * G + c; if (L >= 32) return false; const int l = L >> 4, rem = L & 15;
        u.pm = l * 4 + (rem >> 2); u.pn = rem & 3; u.pb = l * (int)(WL_SIZE / (256 * 1024 * 2)) + (rem & 3); u.po = u.pm; return true; }
};
static_assert(WL_SIZE % (256 * 1024 * 2) == 0, "per-layer weight block must be a whole number of 256 x 1024 bf16 tiles");

struct Args { const float* in[23]; float* out; unsigned char* ws; int ph_lo, ph_hi; };
#define RUN() (lo <= ph && ph < hi)
#define SEAM() do { if (lo <= ph && ph + 1 < hi) { for (int _b = 0; _b < REPS(3); ++_b) xcd_barrier(bar, phase_frame(F0).tid); } ++ph; } while (0)
#define wsb (args.ws)
#define x_in (args.in[0])
#define mem (args.in[1])
#define norm_mix (args.in[2])
#define w_in (args.in[3])
#define w_pa (args.in[4])
#define w_pb (args.in[5])
#define w_pc (args.in[6])
#define w_mix (args.in[7])
#define sinks (args.in[8])
#define norm_cross (args.in[9])
#define norm_mem (args.in[10])
#define w_xq (args.in[11])
#define w_xkv (args.in[12])
#define w_xo (args.in[13])
#define norm_ffn (args.in[14])
#define ffn_gate (args.in[15])
#define ffn_up (args.in[16])
#define ffn_down (args.in[17])
#define moe_router (args.in[18])
#define moe_gate (args.in[19])
#define moe_up (args.in[20])
#define moe_down (args.in[21])
#define final_norm (args.in[22])
#define xres ((bf16*)(wsb + WS_XRES))
#define XN ((bf16*)(wsb + WS_XN))
#define ropec ((float*)(wsb + WS_ROPE))
#define ropes ((float*)(wsb + WS_ROPE) + T * 32)
#define kmean ((float*)(wsb + WS_KMEAN))
#define tok_e ((int*)(wsb + WS_ROUTE + RT_TOKE))
#define tok_w ((float*)(wsb + WS_ROUTE + RT_TOKW))
#define tok_slot ((int*)(wsb + WS_ROUTE + RT_SLOT))
#define rowmap ((int*)(wsb + WS_ROUTE + RT_ROWMAP))
#define meta ((int*)(wsb + WS_ROUTE + RT_META))
template <int l> __device__ __forceinline__ void layer_body(const Args& args, const Frame& F0, const XcdBarrier& bar, const int lo, const int hi, int& ph) {
        unsigned char* wl = wsb + WS_W + (size_t)l * WL_SIZE;
        if (RUN()) for (int rep = 0; rep < REPS(4); ++rep) {
            if (l == 0) { const Frame F = phase_frame(F0);
                pg8::Gemm g{(const bf16*)(wsb + WS_MEMN), (const bf16*)(wsb + WS_W + WL_XKV), D, nullptr}; KvOrder S{F.G, (int)((blockIdx.x + F.G - (INPROJ_I8 ? 192 : ((GATE8_LAYERS >> l) & 1) ? 128 : 64)) % F.G)}; EpiKvMem E{wsb};
                pg8::gemm_phase<EpiKvMem, KvOrder>(F.lds, F.tid, g, S, E); }
            if (INPROJ_I8) { const Frame F = phase_frame(F0);
              pg8::Gemm g{XN, (const bf16*)(wl + WL_IN), D, nullptr}; pg8::StaticOrder S; S.init(M, INW, F.G, (int)blockIdx.x);
              EpiInprojT<true> E{wsb, ropec, ropes, F.lds + RING_BYTES + 1024, (const float*)(wsb + WS_ROUTE + RT_RTOK), (const unsigned*)(wsb + WS_CTL + CTL_CMAX_IN) + l * INW};
              pg8::gemm_phase<EpiInprojT<true>, pg8::StaticOrder, false, true, 2>(F.lds, F.tid, g, S, E); }
            else { const Frame F = phase_frame(F0);
              pg8::Gemm g{XN, (const bf16*)(wl + WL_IN), D, nullptr}; pg8::StaticOrder S; S.init(M, ((GATE8_LAYERS >> l) & 1) ? 2304 : INW, F.G, (int)blockIdx.x); EpiInproj E{wsb, ropec, ropes, F.lds + RING_BYTES + 1024};
              pg8::gemm_phase<EpiInproj, pg8::StaticOrder>(F.lds, F.tid, g, S, E); }
            if ((GATE8_LAYERS >> l) & 1) { const Frame F = phase_frame(F0);
              pg8::Gemm g{(const bf16*)(wsb + WS_XN8), (const bf16*)(wl + WL_IN + WL_IN_G8), D, nullptr}; GateOrder S; S.init(F.G, (int)blockIdx.x, 64); EpiGates8 E{wsb};
              pg8::gemm_phase<EpiGates8, GateOrder, false, true, true>(F.lds, F.tid, g, S, E); }
            if (l == 0 && INPROJ_I8 && rep == 0) { const Frame F = phase_frame(F0); const int c = (int)blockIdx.x;
              if (F.G == 256 && c >= 64 && (c < 192 || c >= 224)) moe_conv_tail(F, 0, c < 192 ? c - 64 : 128 + (c - 224), MOE_TAIL_A0, moe_gate, moe_up, moe_down); }
        }
        SEAM();
        if (RUN()) for (int rep = 0; rep < REPS(6); ++rep) { const Frame F = phase_frame(F0); kmean_phase(F, kmean); }
        SEAM();
        if (RUN()) for (int rep = 0; rep < REPS(1); ++rep) {
            const Frame F = phase_frame(F0);
            for (int vb0 = blockIdx.x; vb0 < 256; vb0 += F.G) {
                const int xc = vb0 & 7, yc = vb0 >> 3; const int vb = ((2 * xc + (yc & 1)) << 4) | (yc >> 1), vbs = xc * 32 + yc;
                { const int bh = vb >> 4, r = vb & 15, j = r >> 1, half = r & 1; const int ob = (F.wave < 4) ? j : 15 - j; const int qt = ob * 8 + half * 4 + (F.wave & 3);
                  if (MOBA_LDS) moba_wg(F, bh >> 2, bh & 3, qt, ((((15 - j) * 8 + half * 4 + 3) >> 1) + 1), kmean); else moba_item(F, bh >> 2, bh & 3, qt, kmean); }
#pragma unroll 1
                for (int k = 0; k < 2; ++k) { const int item = 16 * vbs + 8 * k + F.wave; const int bh = item >> 7; swa_item(F, bh >> 3, bh & 7, item & 127, sinks + l * 8); }
                { const int item = 8 * vb + F.wave; const int bh = item >> 7; sb_item(F, bh >> 2, bh & 3, item & 127); }
            }
        }
        SEAM();
        if (RUN()) for (int rep = 0; rep < REPS(5); ++rep) {
            const Frame F = phase_frame(F0);
            pg8::Gemm g{(const bf16*)(wsb + WS_O), (const bf16*)(wl + WL_PA), D, nullptr}; pg8::StaticOrder S; S.init(M, D, F.G, (int)blockIdx.x);
            EpiGateMix E{(const bf16*)(wsb + WS_G), (bf16*)(wsb + WS_UBF)}; pg8::gemm_phase<EpiGateMix, pg8::StaticOrder>(F.lds, F.tid, g, S, E);
        }
        SEAM();
        if (RUN()) { const Frame F = phase_frame(F0); pg8::Gemm g{(const bf16*)(wsb + WS_UBF), (const bf16*)(wl + WL_MIX), D, nullptr}; pg8::StaticOrder S; S.init(M, D, F.G, (int)blockIdx.x);
            EpiResid<l == 0> E{x_in, xres, xres}; pg8::gemm_phase<EpiResid<l == 0>, pg8::StaticOrder>(F.lds, F.tid, g, S, E); }
        SEAM();
        if (RUN()) for (int rep = 0; rep < REPS(2); ++rep) { const Frame F = phase_frame(F0); if (XQ8) norm_rows<false, true, true, true>(F, xres, norm_cross + l * D, XN, M, nullptr, nullptr, nullptr); else norm_rows<false>(F, xres, norm_cross + l * D, XN, M, nullptr, nullptr, nullptr); }
        SEAM();
        if (RUN()) { const Frame F = phase_frame(F0); pg8::Gemm g{XN, (const bf16*)(wl + WL_XQ), D, nullptr}; pg8::StaticOrder S; S.init(M, XW, F.G, (int)blockIdx.x);
            EpiXq E{(bf16*)(wsb + WS_QX), XQ8 ? QSCALE128 * F8_WINV : QSCALE128}; pg8::gemm_phase<EpiXq, pg8::StaticOrder, false, true, XQ8 != 0>(F.lds, F.tid, g, S, E);
            if (l == 0) { const Frame F2 = phase_frame(F0); const int c = (int)blockIdx.x;
              if (F2.G == 256 && c >= 128) moe_conv_tail(F2, MOE_TAIL_B6, c - 128, MOE_TAIL_A6, moe_gate, moe_up, moe_down); } }
        SEAM();
        if (RUN()) for (int rep = 0; rep < REPS(7); ++rep) {
            const Frame F = phase_frame(F0);
            for (int item = blockIdx.x * NWAVES + F.wave; item < NB * 4 * 128; item += F.G * NWAVES) { const int bh = item >> 7; cross_item(F, l, bh >> 2, bh & 3, item & 127); }
        }
        SEAM();
        if (RUN()) { const Frame F = phase_frame(F0); pg8::Gemm g{(const bf16*)(wsb + WS_OX), (const bf16*)(wl + WL_XO), XW, nullptr}; pg8::StaticOrder S; S.init(M, D, F.G, (int)blockIdx.x);
            EpiResid<false> E{nullptr, xres, xres}; pg8::gemm_phase<EpiResid<false>, pg8::StaticOrder>(F.lds, F.tid, g, S, E); }
        SEAM();
        if (l == 0) {
            if (RUN()) for (int rep = 0; rep < REPS(2); ++rep) { const Frame F = phase_frame(F0); norm_rows<false, true, true, 2>(F, xres, norm_ffn, XN, M, nullptr, nullptr, nullptr, nullptr, nullptr, (float*)(wsb + WS_ROUTE + RT_RTOK)); }
            SEAM();
            if (RUN()) for (int rep = 0; rep < REPS(9); ++rep) { const Frame F = phase_frame(F0); pg8::Gemm g{XN, (const bf16*)(wsb + WS_FFN_GU), D, nullptr}; pg8::StaticOrder S; S.init(M, 2 * DFF, F.G, (int)blockIdx.x);
                EpiSwigluI8 E{(bf16*)(wsb + WS_HFFN), HFFN_LD, (const float*)(wsb + WS_ROUTE + RT_RTOK), (const unsigned*)(wsb + WS_CTL + CTL_CMAX)}; pg8::gemm_phase<EpiSwigluI8, pg8::StaticOrder, false, true, 2>(F.lds, F.tid, g, S, E);
                if (rep == 0) { const Frame F2 = phase_frame(F0); const int c = (int)blockIdx.x;
                  if (F2.G == 256 && c >= 128) moe_conv_tail(F2, MOE_TAIL_B10, c - 128, MOE_TAIL_A10, moe_gate, moe_up, moe_down); } }
            SEAM();
            if (RUN()) for (int rep = 0; rep < REPS(12); ++rep) { const Frame F = phase_frame(F0); pg8::Gemm g{(const bf16*)(wsb + WS_HFFN), (const bf16*)(wsb + WS_FFN_DN), DFF, nullptr, HFFN_LD, HFFN_LD}; pg8::StaticOrder S; S.init(M, D, F.G, (int)blockIdx.x);
                EpiResid<false> E{nullptr, xres, (rep + 1 < REPS(12)) ? (bf16*)(wsb + WS_G + 32 * MiB) : xres}; pg8::gemm_phase<EpiResid<false>, pg8::StaticOrder>(F.lds, F.tid, g, S, E); }
            SEAM();
            if (RUN()) for (int rep = 0; rep < REPS(2); ++rep) { const Frame F = phase_frame(F0); if (INPROJ_I8) norm_rows<false, true, true, 2>(F, xres, norm_mix + D, XN, M, nullptr, nullptr, nullptr, nullptr, nullptr, (float*)(wsb + WS_ROUTE + RT_RTOK));
                else if (GATE8_LAYERS & 2) norm_rows<false, true, true, false, true>(F, xres, norm_mix + D, XN, M, nullptr, nullptr, nullptr, nullptr, wsb + WS_XN8); else norm_rows<false>(F, xres, norm_mix + D, XN, M, nullptr, nullptr, nullptr); }
            SEAM();
        } else {
            if (RUN()) { const Frame F = phase_frame(F0); norm_rows<true, true, true, true>(F, xres, norm_ffn + D, XN, M, moe_router, tok_e, tok_w); }
            SEAM();
            if (RUN()) { const Frame F = phase_frame(F0); if (blockIdx.x == 0) moe_route(F, tok_e, tok_slot, rowmap, meta); }
            SEAM();
            const bool any_moe = (lo <= ph + 3 && ph < hi);
            const int RT = any_moe ? meta[0] : 0;
            const int n0c = RT < MOE_CHUNK_RT ? RT : MOE_CHUNK_RT, rem = RT - n0c, X = (rem > MOE_CHUNK_RT) ? MOE_X : 0, n1 = rem - X;
            if (RUN()) for (int rep = 0; rep < REPS(10); ++rep) { const Frame F = phase_frame(F0); pg8::Gemm g{XN, (const bf16*)(wsb + WS_MOE_GU), D, rowmap}; pg8::MoeOrder<true> S; S.init(n0c + X, 2 * DFE, F.G, (int)blockIdx.x, n0c, 0, n0c + n1, 0, 0, meta + 16);
                EpiSwiglu8 E{wsb + WS_HMOE, DFE}; pg8::gemm_phase<EpiSwiglu8, pg8::MoeOrder<true>, true, true, true>(F.lds, F.tid, g, S, E); }
            SEAM();
            if (RUN()) { const Frame F = phase_frame(F0); pg8::Gemm g{(const bf16*)(wsb + WS_HMOE), (const bf16*)(wsb + WS_MOE_DN), DFE, nullptr}; pg8::MoeOrder<false> S; S.init(n0c, D, F.G, (int)blockIdx.x, n0c, 0, 0, 0, 0, meta + 16);
                EpiBf16Out E{(bf16*)(wsb + WS_Y), D, F8_WINV}; pg8::gemm_phase<EpiBf16Out, pg8::MoeOrder<false>, false, true, true>(F.lds, F.tid, g, S, E); }
            SEAM();
            if (RUN()) {
                { const Frame F = phase_frame(F0); pg8::Gemm g{(const bf16*)(wsb + WS_HMOE), (const bf16*)(wsb + WS_MOE_DN), DFE, nullptr}; pg8::MoeOrder<false> S; S.init(X, D, F.G, (int)blockIdx.x, X, n0c + n1, 0, n0c, 0, meta + 16);
                  EpiBf16Out E{(bf16*)(wsb + WS_Y), D, F8_WINV}; pg8::gemm_phase<EpiBf16Out, pg8::MoeOrder<false>, false, true, true>(F.lds, F.tid, g, S, E); }
                { const Frame F = phase_frame(F0); pg8::Gemm g{XN, (const bf16*)(wsb + WS_MOE_GU), D, rowmap}; pg8::MoeOrder<true> S; S.init(n1, 2 * DFE, F.G, (int)blockIdx.x, n1, n0c, 0, 0, 4 * X, meta + 16);
                  EpiSwiglu8 E{wsb + WS_HMOE, DFE}; pg8::gemm_phase<EpiSwiglu8, pg8::MoeOrder<true>, true, true, true>(F.lds, F.tid, g, S, E); }
            }
            SEAM();
            if (RUN()) { const Frame F = phase_frame(F0); pg8::Gemm g{(const bf16*)(wsb + WS_HMOE), (const bf16*)(wsb + WS_MOE_DN), DFE, nullptr}; pg8::MoeOrder<false> S; S.init(n1, D, F.G, (int)blockIdx.x, n1, n0c, 0, 0, 0, meta + 16);
                EpiBf16Out E{(bf16*)(wsb + WS_Y), D, F8_WINV}; pg8::gemm_phase<EpiBf16Out, pg8::MoeOrder<false>, false, true, true>(F.lds, F.tid, g, S, E); }
            SEAM();
            if (RUN()) { const Frame F = phase_frame(F0); combine_final(F, xres, (const bf16*)(wsb + WS_Y), tok_slot, tok_w, final_norm, args.out); }
            SEAM();
        }
}
__global__ void __launch_bounds__(NWAVES * 64, 2) mk_fwd(Args args) {
    extern __shared__ __attribute__((aligned(16))) unsigned char lds_raw[];
    Frame F0;
    F0.lds = (LAS unsigned char*)lds_raw;
    { const int t0 = threadIdx.x; F0.tid = 0; F0.lane = 0; F0.wave = __builtin_amdgcn_readfirstlane(t0 >> 6); F0.G = gridDim.x; F0.ws = args.ws;
      for (int u = t0; u < (LDS_BYTES - RING_BYTES) / 4; u += NWAVES * 64) ((LAS unsigned*)(F0.lds + RING_BYTES))[u] = 0u; }
    volatile LAS unsigned* MISC = (volatile LAS unsigned*)(F0.lds + MISC_OFF);
    __syncthreads();
    unsigned* ctl = (unsigned*)(args.ws + WS_CTL);
    XcdBarrier bar = xcd_barrier_post(ctl + CW_BAR, MISC + 8, phase_frame(F0).tid);
    const int lo = args.ph_lo, hi = args.ph_hi;
    int ph = 0;
    if (RUN()) { const Frame F = phase_frame(F0); int rot = 0; colmax_matrix<2>(F, rot, ffn_gate, ffn_up, DFF, D, 2 * DFF, (unsigned*)(wsb + WS_CTL + CTL_CMAX));
        if (INPROJ_I8) for (int l = 0; l < 2; ++l) colmax_matrix<1>(F, rot, w_in + (size_t)l * D * INW, nullptr, INW, D, INW, (unsigned*)(wsb + WS_CTL + CTL_CMAX_IN) + l * INW); }
    SEAM();
    if (RUN()) for (int rep = 0; rep < REPS(0); ++rep) {
        const Frame F = phase_frame(F0);
        LAS float* scr = (LAS float*)(F.lds + F.wave * 16896);
        LAS float* scr8 = scr;
        { const int gt = blockIdx.x * (NWAVES * 64) + F.tid, NT = F.G * NWAVES * 64;
          for (int idx = gt; idx < T * 32; idx += NT) { const int pos = idx >> 5, i = idx & 31; const float inv = powf(10000.0f, -(float)i / 32.0f); const float ang = (float)pos * inv;
              ropec[idx] = cosf(ang); ropes[idx] = sinf(ang); } }
        int rot = 0;
        transpose_matrix<2, 2>(F, rot, ffn_gate, ffn_up, DFF, D, 2 * DFF, (bf16*)(wsb + WS_FFN_GU), scr, 0, (const unsigned*)(wsb + WS_CTL + CTL_CMAX));
        if (INPROJ_I8) for (int l = 0; l < 2; ++l) transpose_matrix<1, 2>(F, rot, w_in + (size_t)l * D * INW, nullptr, INW, D, INW, (bf16*)(wsb + WS_W + (size_t)l * WL_SIZE + WL_IN), scr, 0, (const unsigned*)(wsb + WS_CTL + CTL_CMAX_IN) + l * INW);
        {
            const int NGW = F.G * NWAVES, q0 = (F.G == 256) ? MOE_TAIL_ITEMS : 0; int gw = blockIdx.x * NWAVES + F.wave - rot; if (gw < 0) gw += NGW;
            for (int q = q0 + gw; q < MOE_ITEMS; q += NGW) moe_conv_item(q, moe_gate, moe_up, moe_down, wsb, scr8, F.lane);
            rot = (rot + (MOE_ITEMS - q0)) % NGW;
        }
        transpose_matrix<0>(F, rot, ffn_down, nullptr, D, DFF, D, (bf16*)(wsb + WS_FFN_DN), scr, HFFN_LD);
        for (int l = 0; l < 2; ++l) {
            unsigned char* wl = wsb + WS_W + (size_t)l * WL_SIZE;
            if (INPROJ_I8) { }
            else if ((GATE8_LAYERS >> l) & 1) { transpose_matrix<1>(F, rot, w_in + (size_t)l * D * INW, nullptr, INW, D, 2304, (bf16*)(wl + WL_IN), scr);
                transpose_matrix<0, true>(F, rot, w_in + (size_t)l * D * INW + 2304, nullptr, INW, D, 3072, (bf16*)(wl + WL_IN + WL_IN_G8), scr); }
            else transpose_matrix<1>(F, rot, w_in + (size_t)l * D * INW, nullptr, INW, D, INW, (bf16*)(wl + WL_IN), scr);
            transpose_matrix<0>(F, rot, w_pa + (size_t)l * 256 * D, nullptr, D, 256, D, (bf16*)(wl + WL_PA), scr, D);
            transpose_matrix<0>(F, rot, w_pb + (size_t)l * 512 * D, nullptr, D, 512, D, (bf16*)(wl + WL_PA) + 256, scr, D);
            transpose_matrix<0>(F, rot, w_pc + (size_t)l * 256 * D, nullptr, D, 256, D, (bf16*)(wl + WL_PA) + 768, scr, D);
            transpose_matrix<0>(F, rot, w_mix + (size_t)l * D * D, nullptr, D, D, D, (bf16*)(wl + WL_MIX), scr);
            transpose_matrix<0, XQ8 != 0>(F, rot, w_xq + (size_t)l * D * XW, nullptr, XW, D, XW, (bf16*)(wl + WL_XQ), scr);
            transpose_matrix<0>(F, rot, w_xkv + (size_t)l * D * 2 * XW, nullptr, 2 * XW, D, 2 * XW, (bf16*)(wl + WL_XKV), scr);
            transpose_matrix<0>(F, rot, w_xo + (size_t)l * XW * D, nullptr, D, XW, D, (bf16*)(wl + WL_XO), scr);
            norm_rows<false, false>(F, mem, norm_mem + l * D, (bf16*)(wsb + WS_MEMN) + (size_t)l * NB * MEML * D, NB * MEML, nullptr, nullptr, nullptr);
        }
        if (INPROJ_I8) norm_rows<false, false, true, 2>(F, x_in, norm_mix, XN, M, nullptr, nullptr, nullptr, nullptr, nullptr, (float*)(wsb + WS_ROUTE + RT_RTOK));
        else if (GATE8_LAYERS & 1) norm_rows<false, false, true, false, true>(F, x_in, norm_mix, XN, M, nullptr, nullptr, nullptr, nullptr, wsb + WS_XN8); else norm_rows<false, false>(F, x_in, norm_mix, XN, M, nullptr, nullptr, nullptr);
    }
    SEAM();

    layer_body<0>(args, F0, bar, lo, hi, ph);
    layer_body<1>(args, F0, bar, lo, hi, ph);
#undef RUN
#undef SEAM
}
#undef wsb
#undef x_in
#undef mem
#undef xres
#undef XN
#undef ropec
#undef ropes
#undef kmean
#undef tok_e
#undef tok_w
#undef tok_slot
#undef rowmap
#undef meta
#undef sinks
#undef norm_mix
#undef w_in
#undef w_pa
#undef w_pb
#undef w_pc
#undef w_mix
#undef norm_cross
#undef norm_mem
#undef w_xq
#undef w_xkv
#undef w_xo
#undef norm_ffn
#undef ffn_gate
#undef ffn_up
#undef ffn_down
#undef moe_router
#undef moe_gate
#undef moe_up
#undef moe_down
#undef final_norm

extern "C" void kernel_launch(void* const* d_in, const int* in_sizes, int n_in, void* d_out, int out_size, void* d_ws, size_t ws_size, hipStream_t stream) {
    static int grid = 0;
    if (grid == 0) {
        if (n_in != 23 || in_sizes[0] != M * D || out_size != M * D || ws_size < WS_END) { fprintf(stderr, "kernel_launch: unexpected shapes / workspace (n_in %d, wsb %zu < %zu); nothing launched\n", n_in, ws_size, (size_t)WS_END); grid = -1; return; }
        int dev = 0, cus = 0, per_cu = 0;
        if (hipGetDevice(&dev) != hipSuccess || hipDeviceGetAttribute(&cus, hipDeviceAttributeMultiprocessorCount, dev) != hipSuccess) { grid = -1; return; }
        if (hipFuncSetAttribute((const void*)mk_fwd, hipFuncAttributeMaxDynamicSharedMemorySize, LDS_BYTES) != hipSuccess) { fprintf(stderr, "kernel_launch: hipFuncSetAttribute failed\n"); grid = -1; return; }
        if (hipOccupancyMaxActiveBlocksPerMultiprocessor(&per_cu, (const void*)mk_fwd, NWAVES * 64, LDS_BYTES) != hipSuccess || per_cu < 1)
            fprintf(stderr, "kernel_launch: note: occupancy query reports %d workgroups per CU\n", per_cu);
        (void)hipGetLastError();
        grid = cus;
    }
    if (grid < 0) return;
    if (hipMemsetAsync((char*)d_ws + WS_CTL, 0, CTL_ZERO_BYTES, stream) != hipSuccess) return;
    Args a{};
    for (int i = 0; i < 23; ++i) a.in[i] = (const float*)d_in[i];
    a.out = (float*)d_out; a.ws = (unsigned char*)d_ws;
#if MK_PER_PHASE
    for (int k = 0; k < N_PHASES; ++k) { a.ph_lo = k; a.ph_hi = k + 1; hipLaunchKernelGGL(mk_fwd, dim3(grid), dim3(NWAVES * 64), LDS_BYTES, stream, a); }
#else
    a.ph_lo = 0; a.ph_hi = N_PHASES; hipLaunchKernelGGL(mk_fwd, dim3(grid), dim3(NWAVES * 64), LDS_BYTES, stream, a);
#endif
}
```
